# Optimizing an MI355X kernel written in HIP

```python
import jax, jax.numpy as jnp
from jax import lax
import numpy as np

D_MODEL = 2048
BATCH = 1
SEQ = 8192
DEPTH = 4

GRID_W = 64
D_CONV = D_MODEL // 2
CONV_A_W = 3
D_LRU = D_MODEL // 2
LRU_HEADS = 8
LRU_HD = D_LRU // LRU_HEADS
CONV_B_W = 4
RG_C = 8.0
NA_HEADS = 16
NA_HD = D_MODEL // NA_HEADS
WIN_ROWS = 8
WIN_COLS = 16
PEER_HEADS = 8
PEER_QDIM = 256
N_KEYS = 128
N_EXPERTS = N_KEYS * N_KEYS
PEER_TOPK = 16
PEER_CHUNK = 128
ALPHA = (2 * DEPTH) ** 0.25
BETA = (8 * DEPTH) ** -0.25
LN_EPS = 1e-5
N_EVEN = (DEPTH + 1) // 2
N_ODD = DEPTH // 2

kernel_name = "hybrid_conv_rglru_natten_peer_encoder"


def layer_norm(x, g, b):
    xf = x.astype(jnp.float32)
    mu = jnp.mean(xf, axis=-1, keepdims=True)
    var = jnp.mean(jnp.square(xf - mu), axis=-1, keepdims=True)
    y = (xf - mu) * lax.rsqrt(var + LN_EPS) * g.astype(jnp.float32) + b.astype(jnp.float32)
    return y.astype(x.dtype)


def depthwise_conv(x, w, pad_l, pad_r):
    return lax.conv_general_dilated(
        x, w[:, None, :], window_strides=(1,), padding=[(pad_l, pad_r)],
        dimension_numbers=("NWC", "WIO", "NWC"), feature_group_count=x.shape[-1])


def _lin_combine(left, right):
    a_l, b_l = left
    a_r, b_r = right
    return a_l * a_r, a_r * b_l + b_r


def rglru_direction(xb, conv_w, conv_b, w_r, b_r, w_i, b_i, lam, reverse):
    pad = (0, CONV_B_W - 1) if reverse else (CONV_B_W - 1, 0)
    xc = depthwise_conv(xb, conv_w, pad[0], pad[1]) + conv_b
    B, S, _ = xc.shape
    xh = xc.reshape(B, S, LRU_HEADS, LRU_HD)
    r = jax.nn.sigmoid((jnp.einsum("bshi,hij->bshj", xh, w_r).reshape(B, S, D_LRU) + b_r).astype(jnp.float32))
    i = jax.nn.sigmoid((jnp.einsum("bshi,hij->bshj", xh, w_i).reshape(B, S, D_LRU) + b_i).astype(jnp.float32))
    log_a = -RG_C * r * jax.nn.softplus(-lam.astype(jnp.float32))
    a = jnp.exp(log_a)
    u = jnp.sqrt(-jnp.expm1(2.0 * log_a)) * i * xc.astype(jnp.float32)
    _, h = lax.associative_scan(_lin_combine, (a, u), reverse=reverse, axis=1)
    return h


def short_conv_rglru_mixer(x, w_in, conv_a, conv_b_w, conv_b_b, w_r, b_r, w_i, b_i, lam, w_out):
    z = x @ w_in
    gate_b, gate_c, xa, gate_g, xb = jnp.split(
        z, [D_CONV, 2 * D_CONV, 3 * D_CONV, 3 * D_CONV + D_LRU], axis=-1)
    y_a = gate_b * depthwise_conv(gate_c * xa, conv_a, CONV_A_W // 2, CONV_A_W // 2)
    h = (rglru_direction(xb, conv_b_w[0], conv_b_b[0], w_r[0], b_r[0], w_i[0], b_i[0], lam[0], False)
         + rglru_direction(xb, conv_b_w[1], conv_b_b[1], w_r[1], b_r[1], w_i[1], b_i[1], lam[1], True))
    y_b = jax.nn.gelu(gate_g, approximate=False) * h.astype(x.dtype)
    return jnp.concatenate([y_a, y_b], axis=-1) @ w_out


def neighbourhood_attention(x, w_qkv, rel_bias, w_o):
    B, S, D = x.shape
    rows = S // GRID_W
    kh = min(WIN_ROWS, rows)
    kw = WIN_COLS
    qkv = (x @ w_qkv).reshape(B, rows, GRID_W, 3, NA_HEADS, NA_HD)
    q = qkv[:, :, :, 0] * (NA_HD ** -0.5)
    k = qkv[:, :, :, 1]
    v = qkv[:, :, :, 2]
    r = jnp.arange(rows)
    c = jnp.arange(GRID_W)
    row_start = jnp.clip(r - kh // 2, 0, rows - kh)
    row_idx = row_start[:, None] + jnp.arange(kh)[None, :]
    col_start = jnp.clip(c - kw // 2, 0, GRID_W - kw)
    col_mask = (c[None, :] >= col_start[:, None]) & (c[None, :] < col_start[:, None] + kw)
    k_band = k[:, row_idx]
    v_band = v[:, row_idx]
    roff = row_idx - r[:, None] + (WIN_ROWS - 1)
    coff = jnp.clip(c[None, :] - c[:, None], -(kw - 1), kw - 1) + (WIN_COLS - 1)
    bias = rel_bias[:, roff[:, None, :, None], coff[None, :, None, :]]
    s = jnp.einsum("brqhd,brkjhd->bhrqkj", q, k_band).astype(jnp.float32) + bias.astype(jnp.float32)[None]
    s = jnp.where(col_mask[:, None, :], s, -1e30)
    p = jax.nn.softmax(s.reshape(B, NA_HEADS, rows, GRID_W, kh * GRID_W), axis=-1)
    p = p.reshape(s.shape).astype(v.dtype)
    o = jnp.einsum("bhrqkj,brkjhd->brqhd", p, v_band).reshape(B, S, D)
    return o @ w_o


def peer(x, w_q, sub_keys, u, v):
    B, S, D = x.shape
    T = B * S
    xt = x.reshape(T, D)
    q = (xt @ w_q).reshape(T, PEER_HEADS, 2, PEER_QDIM // 2)
    s = jnp.einsum("thpd,pkd->thpk", q, sub_keys).astype(jnp.float32)
    sv, si = lax.top_k(s, PEER_TOPK)
    cand = (sv[:, :, 0, :, None] + sv[:, :, 1, None, :]).reshape(T, PEER_HEADS, PEER_TOPK * PEER_TOPK)
    cv, ci = lax.top_k(cand, PEER_TOPK)
    e = (jnp.take_along_axis(si[:, :, 0], ci // PEER_TOPK, axis=-1) * N_KEYS
         + jnp.take_along_axis(si[:, :, 1], ci % PEER_TOPK, axis=-1))
    g = jax.nn.softmax(cv, axis=-1).astype(x.dtype)

    def chunk_fn(args):
        xc, ec, gc = args
        act = jax.nn.gelu(jnp.einsum("td,thkd->thk", xc, u[ec]), approximate=False)
        return jnp.einsum("thk,thkd->td", gc * act, v[ec])

    n = T // PEER_CHUNK
    y = lax.map(chunk_fn, (xt.reshape(n, PEER_CHUNK, D),
                           e.reshape(n, PEER_CHUNK, PEER_HEADS, PEER_TOPK),
                           g.reshape(n, PEER_CHUNK, PEER_HEADS, PEER_TOPK)))
    return y.reshape(B, S, D)


def setup_inputs(seed: int = 0) -> dict:
    key = jax.random.key(seed)
    ks = jax.random.split(key, 24)

    def nrm(k, shape, scale):
        return jax.random.normal(k, shape, jnp.float32) * scale

    x = nrm(ks[0], (BATCH, SEQ, D_MODEL), 1.0)
    ev_w_in = nrm(ks[1], (N_EVEN, D_MODEL, 3 * D_CONV + 2 * D_LRU), D_MODEL ** -0.5)
    ev_conv_a = nrm(ks[2], (N_EVEN, CONV_A_W, D_CONV), CONV_A_W ** -0.5)
    ev_conv_b_w = nrm(ks[3], (N_EVEN, 2, CONV_B_W, D_LRU), CONV_B_W ** -0.5)
    ev_conv_b_b = nrm(ks[4], (N_EVEN, 2, D_LRU), 0.01)
    ev_w_r = nrm(ks[5], (N_EVEN, 2, LRU_HEADS, LRU_HD, LRU_HD), LRU_HD ** -0.5)
    ev_b_r = nrm(ks[6], (N_EVEN, 2, D_LRU), 0.01)
    ev_w_i = nrm(ks[7], (N_EVEN, 2, LRU_HEADS, LRU_HD, LRU_HD), LRU_HD ** -0.5)
    ev_b_i = nrm(ks[8], (N_EVEN, 2, D_LRU), 0.01)
    a_c = jax.random.uniform(ks[9], (N_EVEN, 2, D_LRU), jnp.float32, minval=0.9, maxval=0.999)
    a_base = a_c ** (1.0 / RG_C)
    ev_lam = jnp.log(a_base) - jnp.log1p(-a_base)
    ev_w_out = nrm(ks[10], (N_EVEN, D_CONV + D_LRU, D_MODEL), BETA * (D_CONV + D_LRU) ** -0.5)
    qkv_scale = jnp.concatenate([jnp.ones((2 * D_MODEL,), jnp.float32), jnp.full((D_MODEL,), BETA, jnp.float32)])
    od_w_qkv = nrm(ks[11], (N_ODD, D_MODEL, 3 * D_MODEL), D_MODEL ** -0.5) * qkv_scale
    od_rel_bias = nrm(ks[12], (N_ODD, NA_HEADS, 2 * WIN_ROWS - 1, 2 * WIN_COLS - 1), 0.02)
    od_w_o = nrm(ks[13], (N_ODD, D_MODEL, D_MODEL), BETA * D_MODEL ** -0.5)
    pk_w_q = nrm(ks[14], (DEPTH, D_MODEL, PEER_HEADS * PEER_QDIM), D_MODEL ** -0.5)
    pk_sub_keys = nrm(ks[15], (DEPTH, 2, N_KEYS, PEER_QDIM // 2), (PEER_QDIM // 2) ** -0.5)
    pk_u = nrm(ks[16], (DEPTH, N_EXPERTS, D_MODEL), D_MODEL ** -0.5)
    pk_v = nrm(ks[17], (DEPTH, N_EXPERTS, D_MODEL), BETA * PEER_HEADS ** -0.5)
    ln1_g = 1.0 + nrm(ks[18], (DEPTH, D_MODEL), 0.02)
    ln1_b = nrm(ks[19], (DEPTH, D_MODEL), 0.02)
    ln2_g = 1.0 + nrm(ks[20], (DEPTH, D_MODEL), 0.02)
    ln2_b = nrm(ks[21], (DEPTH, D_MODEL), 0.02)
    return {"x": x, "ev_w_in": ev_w_in, "ev_conv_a": ev_conv_a, "ev_conv_b_w": ev_conv_b_w,
            "ev_conv_b_b": ev_conv_b_b, "ev_w_r": ev_w_r, "ev_b_r": ev_b_r, "ev_w_i": ev_w_i,
            "ev_b_i": ev_b_i, "ev_lam": ev_lam, "ev_w_out": ev_w_out, "od_w_qkv": od_w_qkv,
            "od_rel_bias": od_rel_bias, "od_w_o": od_w_o, "pk_w_q": pk_w_q, "pk_sub_keys": pk_sub_keys,
            "pk_u": pk_u, "pk_v": pk_v, "ln1_g": ln1_g, "ln1_b": ln1_b, "ln2_g": ln2_g, "ln2_b": ln2_b}


def reference(x, ev_w_in, ev_conv_a, ev_conv_b_w, ev_conv_b_b, ev_w_r, ev_b_r, ev_w_i, ev_b_i,
              ev_lam, ev_w_out, od_w_qkv, od_rel_bias, od_w_o, pk_w_q, pk_sub_keys, pk_u, pk_v,
              ln1_g, ln1_b, ln2_g, ln2_b):
    for l in range(DEPTH):
        i = l // 2
        if l % 2 == 0:
            h = short_conv_rglru_mixer(x, ev_w_in[i], ev_conv_a[i], ev_conv_b_w[i], ev_conv_b_b[i],
                                       ev_w_r[i], ev_b_r[i], ev_w_i[i], ev_b_i[i], ev_lam[i], ev_w_out[i])
        else:
            h = neighbourhood_attention(x, od_w_qkv[i], od_rel_bias[i], od_w_o[i])
        x = layer_norm(ALPHA * x + h, ln1_g[l], ln1_b[l])
        x = layer_norm(ALPHA * x + peer(x, pk_w_q[l], pk_sub_keys[l], pk_u[l], pk_v[l]), ln2_g[l], ln2_b[l])
    return x
```

```cpp
#include <hip/hip_runtime.h>
#include <stdint.h>
#include <math.h>
namespace pg8 {
#define PG8_LAS __attribute__((address_space(3)))
typedef unsigned short bf16_t;
typedef short bf16x8 __attribute__((ext_vector_type(8)));
typedef float f32x4 __attribute__((ext_vector_type(4)));
typedef unsigned u32x4 __attribute__((ext_vector_type(4)));
constexpr int BM = 256, BK = 64, HALF = 128, HTB = HALF * BK * 2  , STAGE_BYTES = 8 * HTB, NXCD = 8, WGM = 8;

__host__ __device__ __forceinline__ int lds_byte(int r, int c) { const int st = (r >> 4) * 2 + (c >> 5), rr = r & 15, cc = c & 31, ob = rr * 64 + cc * 2; return st * 1024 + (ob ^ (((ob >> 9) & 1) << 5)); }
__host__ __device__ __forceinline__ void stage_rc(int b, int& R, int& C) { const int st = b / 1024, sb = b % 1024, swz = sb ^ (((sb >> 9) & 1) << 5); R = (st >> 1) * 16 + swz / 64; C = (st & 1) * 32 + (swz % 64) / 2; }
__host__ __device__ __forceinline__ int perm32(int rho) { const int n = rho >> 4, i = rho & 15; return 8 * (i >> 2) + 4 * n + (i & 3); }

struct Unit { int pm, pn; };
struct Gemm { const bf16_t* A; const bf16_t* Bt; int M, N, K, pad_; };

struct StaticOrder {
    int nM, nN, nwg, G, c;
    __host__ __device__ void init(int M, int N, int G_, int c_) { nM = M / BM; nN = N / BM; nwg = nM * nN; G = G_; c = c_; }
    __host__ __device__ bool next(int i, Unit& u) const {
        const long L = (long)i * G + c; if (L >= nwg) return false;
        int wgid = (int)L; { const int q = nwg / NXCD, r = nwg % NXCD, xcd = wgid % NXCD, off = wgid / NXCD; wgid = (xcd < r ? xcd * (q + 1) : r * (q + 1) + (xcd - r) * q) + off; }
        const int nig = WGM * nN, gid = wgid / nig, fm = gid * WGM, gsz = (nM - fm) < WGM ? (nM - fm) : WGM;
        u.pm = fm + ((wgid % nig) % gsz); u.pn = (wgid % nig) / gsz; return true;
    }
    __device__ __forceinline__ void a_ready(const Unit&) const {}
    __device__ __forceinline__ void done(const Unit&) const {}
};
struct CountedOrder : StaticOrder {
    const unsigned* ready; unsigned need; unsigned* tmo;
    __device__ __forceinline__ void a_ready(const Unit& u) const {
        if (threadIdx.x < 64) {
            const unsigned long long t0 = __builtin_amdgcn_s_memrealtime(); unsigned polls = 0;
            while ((unsigned)__builtin_amdgcn_readfirstlane(__hip_atomic_load(ready + 64 * u.pm, __ATOMIC_RELAXED, __HIP_MEMORY_SCOPE_AGENT)) < need) {
                if ((++polls & 255u) == 0u && __builtin_amdgcn_readfirstlane(__hip_atomic_load(tmo, __ATOMIC_RELAXED, __HIP_MEMORY_SCOPE_AGENT)) != 0u) break;
                if (__builtin_amdgcn_s_memrealtime() - t0 > 2000000ull) {
                    if (threadIdx.x == 0) { unsigned expect = 0u; __hip_atomic_compare_exchange_strong(tmo + 1, &expect, 0x600u | (unsigned)(u.pm & 0xff), __ATOMIC_RELAXED, __ATOMIC_RELAXED, __HIP_MEMORY_SCOPE_AGENT); __hip_atomic_store(tmo, 1u, __ATOMIC_RELAXED, __HIP_MEMORY_SCOPE_AGENT); }
                    break; }
                __builtin_amdgcn_s_sleep(2); }
            __builtin_amdgcn_fence(__ATOMIC_ACQUIRE, "agent");
            asm volatile("s_waitcnt vmcnt(0)" ::: "memory");
        }
#if !defined(BROKEN_HOOK_NO_BARRIER)
        asm volatile("" ::: "memory"); __builtin_amdgcn_s_barrier(); asm volatile("" ::: "memory");
#endif
    }
};

__device__ __forceinline__ unsigned cvt_pk_bf16(float lo, float hi) { unsigned r; asm volatile("v_cvt_pk_bf16_f32 %0, %1, %2" : "=v"(r) : "v"(lo), "v"(hi)); return r; }
typedef float f32x2 __attribute__((ext_vector_type(2)));
__device__ __forceinline__ f32x2 gelu_pk(f32x2 v) {
    const f32x2 av = __builtin_elementwise_abs(v), d = av * 0.2316418882f + 1.0f;
    f32x2 t; t.x = __builtin_amdgcn_rcpf(d.x); t.y = __builtin_amdgcn_rcpf(d.y);
    f32x2 q = t * 0.5307027145f + (-0.7265760135f); q = q * t + 0.7107068705f; q = q * t + (-0.142248368f); q = q * t + 0.127414796f; q = q * t;
    const f32x2 s = (v * v) * (-0.72134752044f);
    f32x2 e; e.x = __builtin_amdgcn_exp2f(s.x); e.y = __builtin_amdgcn_exp2f(s.y);
    const f32x2 m = v * (q * e), r = v - m;
    f32x2 o; o.x = v.x < 0.f ? m.x : r.x; o.y = v.y < 0.f ? m.y : r.y; return o;
}

struct EpiF32 {
    static constexpr bool PERM = false, AFTER_DRAIN = false;
    float* C; const float* bias; int ldc; int pad_;
    __device__ __forceinline__ void operator()(const f32x4 (&acc)[2][2][4][2], const Unit& u, int wr, int wc, int fr, int fq) const {
        const int row0 = u.pm * BM + wr * 64 + fr, col0 = u.pn * BM + wc * 32 + 4 * fq;
        f32x4 bv[2][2];
#pragma unroll
        for (int bj = 0; bj < 2; ++bj)
#pragma unroll
            for (int n = 0; n < 2; ++n) bv[bj][n] = bias ? *(const f32x4*)(bias + col0 + bj * HALF + n * 16) : (f32x4){0.f, 0.f, 0.f, 0.f};
#pragma unroll
        for (int ai = 0; ai < 2; ++ai)
#pragma unroll
            for (int m = 0; m < 4; ++m) { float* rowp = C + (size_t)(row0 + ai * HALF + m * 16) * ldc + col0;
#pragma unroll
                for (int bj = 0; bj < 2; ++bj)
#pragma unroll
                    for (int n = 0; n < 2; ++n) *(f32x4*)(rowp + bj * HALF + n * 16) = acc[ai][bj][m][n] + bv[bj][n]; }
    }
};
template <int ACT  > struct EpiBf16 {
    static constexpr bool PERM = true, AFTER_DRAIN = false;
    bf16_t* O; const float* bias; size_t split_stride; int ldc; int split_cols;
    __device__ __forceinline__ void operator()(const f32x4 (&acc)[2][2][4][2], const Unit& u, int wr, int wc, int fr, int fq) const {
        const int row0 = u.pm * BM + wr * 64 + fr; int colt = u.pn * BM; bf16_t* base = O;
        if (split_cols) { const int t = colt / split_cols; base += (size_t)t * split_stride; colt -= t * split_cols; }
        const int col0 = colt + wc * 32 + 8 * fq, bcol0 = u.pn * BM + wc * 32 + 8 * fq;
        f32x4 bv[2][2];
#pragma unroll
        for (int bj = 0; bj < 2; ++bj)
#pragma unroll
            for (int n = 0; n < 2; ++n) bv[bj][n] = bias ? *(const f32x4*)(bias + bcol0 + bj * HALF + 4 * n) : (f32x4){0.f, 0.f, 0.f, 0.f};
#pragma unroll
        for (int ai = 0; ai < 2; ++ai)
#pragma unroll
            for (int m = 0; m < 4; ++m) { bf16_t* rowp = base + (size_t)(row0 + ai * HALF + m * 16) * ldc + col0;
#pragma unroll
                for (int bj = 0; bj < 2; ++bj) { f32x4 v0 = acc[ai][bj][m][0] + bv[bj][0], v1 = acc[ai][bj][m][1] + bv[bj][1];
                    if (ACT == 1) { f32x2 a = gelu_pk((f32x2){v0[0], v0[1]}), b = gelu_pk((f32x2){v0[2], v0[3]}), c = gelu_pk((f32x2){v1[0], v1[1]}), d = gelu_pk((f32x2){v1[2], v1[3]});
                        v0 = (f32x4){a.x, a.y, b.x, b.y}; v1 = (f32x4){c.x, c.y, d.x, d.y}; }
                    if (ACT == 2) {
#pragma unroll
                        for (int j = 0; j < 4; ++j) { v0[j] = 0.5f * v0[j] * (1.0f + erff(v0[j] * 0.70710678f)); v1[j] = 0.5f * v1[j] * (1.0f + erff(v1[j] * 0.70710678f)); } }
                    u32x4 w; w.x = cvt_pk_bf16(v0[0], v0[1]); w.y = cvt_pk_bf16(v0[2], v0[3]); w.z = cvt_pk_bf16(v1[0], v1[1]); w.w = cvt_pk_bf16(v1[2], v1[3]);
                    *(u32x4*)(rowp + bj * HALF) = w; } }
    }
};
struct EpiRes {
    static constexpr bool PERM = false, AFTER_DRAIN = false;
    float* C; const float* X; int ldc; float alpha;
    __device__ __forceinline__ void operator()(const f32x4 (&acc)[2][2][4][2], const Unit& u, int wr, int wc, int fr, int fq) const {
        const int row0 = u.pm * BM + wr * 64 + fr, col0 = u.pn * BM + wc * 32 + 4 * fq;
#pragma unroll
        for (int ai = 0; ai < 2; ++ai)
#pragma unroll
            for (int m = 0; m < 4; ++m) { const size_t ro = (size_t)(row0 + ai * HALF + m * 16) * ldc + col0; float* rowp = C + ro; const float* xp = X + ro;
#pragma unroll
                for (int bj = 0; bj < 2; ++bj)
#pragma unroll
                    for (int n = 0; n < 2; ++n) { const f32x4 xv = *(const f32x4*)(xp + bj * HALF + n * 16); *(f32x4*)(rowp + bj * HALF + n * 16) = acc[ai][bj][m][n] + xv * alpha; } }
    }
};

template <class Epi, class Sched, bool STAMP = false>
__device__ __forceinline__ void gemm_phase(PG8_LAS unsigned char* lds, const Gemm g, const Sched& S, const Epi& E, unsigned long long* stamps) {
    const int tid = threadIdx.x, wid = __builtin_amdgcn_readfirstlane(tid >> 6), lane = tid & 63, wr = wid >> 2, wc = wid & 3, fr = lane & 15, fq = lane >> 4;
    const int K = g.K, nt = K / BK;
    int ts_lo = 0, ts_hi = 0, nts = 0; const unsigned long long rt_entry = STAMP ? (unsigned long long)wall_clock64() : 0ull;
#define PG8_STAMP() do { if (STAMP && wid == 0 && nts < 64) { const unsigned long long _c = (unsigned long long)clock64(); \
        ts_lo = (lane == nts) ? (int)(unsigned)_c : ts_lo; ts_hi = (lane == nts) ? (int)(unsigned)(_c >> 32) : ts_hi; ++nts; } } while (0)
    PG8_STAMP();
    unsigned voffA[2], voffB[2];
#pragma unroll
    for (int i = 0; i < 2; ++i) { int R, C; stage_rc(tid * 16 + i * 8192, R, C); const int Rb = Epi::PERM ? ((R & ~31) + perm32(R & 31)) : R;
        voffA[i] = (unsigned)(R * K + C) * 2u; voffB[i] = (unsigned)(Rb * K + C) * 2u; }
    const size_t kstep = (size_t)(BK * 2);
    const size_t hstep = (size_t)HALF * K * 2;
    const size_t tstep = 2 * hstep;
    const unsigned ldsw = (unsigned)wid * 1024u;
    const int aoff = lds_byte(wr * 64 + fr, fq * 8), boff = lds_byte(wc * 32 + fr, fq * 8);
#define PG8_SA(b, h) (((b) * 2 + (h)) * HTB)
#define PG8_SB(b, h) ((4 + (b) * 2 + (h)) * HTB)
#define PG8_STAGE(bufoff, gbase, voff) do { _Pragma("unroll") for (int _i = 0; _i < 2; ++_i) \
        __builtin_amdgcn_global_load_lds((const unsigned*)((const char*)(gbase) + (voff)[_i]), (PG8_LAS unsigned*)(lds + (bufoff) + ldsw + _i * 8192), 16, 0, 0); } while (0)
#define PG8_LDA(dst, b, h) do { _Pragma("unroll") for (int m = 0; m < 4; ++m) _Pragma("unroll") for (int k = 0; k < 2; ++k) dst[m][k] = *(const PG8_LAS bf16x8*)(lds + PG8_SA(b, h) + aoff + m * 2048 + k * 1024); } while (0)
#define PG8_LDB(dst, b, h) do { _Pragma("unroll") for (int n = 0; n < 2; ++n) _Pragma("unroll") for (int k = 0; k < 2; ++k) dst[n][k] = *(const PG8_LAS bf16x8*)(lds + PG8_SB(b, h) + boff + n * 2048 + k * 1024); } while (0)
#define PG8_MMA(ai, bj, At, Bt) do { __builtin_amdgcn_s_setprio(1); _Pragma("unroll") for (int m = 0; m < 4; ++m) _Pragma("unroll") for (int n = 0; n < 2; ++n) _Pragma("unroll") for (int k = 0; k < 2; ++k) \
        acc[ai][bj][m][n] = __builtin_amdgcn_mfma_f32_16x16x32_bf16(Bt[n][k], At[m][k], acc[ai][bj][m][n], 0, 0, 0); __builtin_amdgcn_s_setprio(0); } while (0)
#define PG8_WAIT_V(n) asm volatile("s_waitcnt vmcnt(" #n ")" ::: "memory")
#define PG8_WAIT_L(n) asm volatile("s_waitcnt lgkmcnt(" #n ")" ::: "memory")
#define PG8_BAR __builtin_amdgcn_s_barrier()
#define PG8_SCHED __builtin_amdgcn_sched_barrier(0)
    Unit cur, nxt; int ui = 0;
    if (!S.next(0, cur)) return;
    f32x4 acc[2][2][4][2];
#pragma unroll
    for (int a = 0; a < 2; ++a)
#pragma unroll
        for (int b = 0; b < 2; ++b)
#pragma unroll
            for (int m = 0; m < 4; ++m)
#pragma unroll
                for (int n = 0; n < 2; ++n) acc[a][b][m][n] = (f32x4){0.f, 0.f, 0.f, 0.f};
    bf16x8 At[4][2], B0[2][2], B1[2][2];
    const char* cA = (const char*)g.A + (size_t)cur.pm * tstep; const char* cB = (const char*)g.Bt + (size_t)cur.pn * tstep;
    S.a_ready(cur);
    PG8_STAGE(PG8_SB(0, 0), cB, voffB); PG8_STAGE(PG8_SA(0, 0), cA, voffA); PG8_STAGE(PG8_SB(0, 1), cB + hstep, voffB); PG8_STAGE(PG8_SA(0, 1), cA + hstep, voffA);
    if (wr == 1) PG8_BAR;
    PG8_WAIT_V(4); PG8_BAR;
    PG8_STAGE(PG8_SB(1, 0), cB + kstep, voffB); PG8_STAGE(PG8_SA(1, 0), cA + kstep, voffA); PG8_STAGE(PG8_SB(1, 1), cB + hstep + kstep, voffB);
    PG8_WAIT_V(6); PG8_BAR;
    PG8_STAMP();
    for (;;) {
        const bool has_next = S.next(ui + 1, nxt);
        const char* nA = has_next ? (const char*)g.A + (size_t)nxt.pm * tstep : cA; const char* nB = has_next ? (const char*)g.Bt + (size_t)nxt.pn * tstep : cB;
        for (int t = 0; t < nt; t += 2) {
            const bool last = (t == nt - 2);
            const char* a1 = cA + (size_t)(t + 1) * kstep;
            const char* a2 = last ? nA : cA + (size_t)(t + 2) * kstep; const char* b2 = last ? nB : cB + (size_t)(t + 2) * kstep;
            const char* a3 = a2 + kstep; const char* b3 = b2 + kstep;
            if (last && has_next) S.a_ready(nxt);
            PG8_LDB(B0, 0, 0); PG8_SCHED; PG8_LDA(At, 0, 0); PG8_STAGE(PG8_SA(1, 1), a1 + hstep, voffA);
            PG8_WAIT_L(8); PG8_BAR; PG8_WAIT_L(0); PG8_MMA(0, 0, At, B0); PG8_BAR; PG8_SCHED;
            PG8_LDB(B1, 0, 1); PG8_STAGE(PG8_SB(0, 0), b2, voffB);
            PG8_BAR; PG8_WAIT_L(0); PG8_MMA(0, 1, At, B1); PG8_BAR;
            PG8_LDA(At, 0, 1); PG8_STAGE(PG8_SA(0, 0), a2, voffA);
            PG8_BAR; PG8_WAIT_L(0); PG8_MMA(1, 0, At, B0); PG8_BAR; PG8_SCHED;
            PG8_STAGE(PG8_SB(0, 1), b2 + hstep, voffB);
            PG8_WAIT_V(6); PG8_BAR; PG8_MMA(1, 1, At, B1); PG8_BAR;
            PG8_LDB(B0, 1, 0); PG8_SCHED; PG8_LDA(At, 1, 0); PG8_STAGE(PG8_SA(0, 1), a2 + hstep, voffA);
            PG8_WAIT_L(8); PG8_BAR; PG8_WAIT_L(0); PG8_MMA(0, 0, At, B0); PG8_BAR; PG8_SCHED;
            PG8_LDB(B1, 1, 1); PG8_STAGE(PG8_SB(1, 0), b3, voffB);
            PG8_BAR; PG8_WAIT_L(0); PG8_MMA(0, 1, At, B1); PG8_BAR;
            PG8_LDA(At, 1, 1); PG8_STAGE(PG8_SA(1, 0), a3, voffA);
            PG8_BAR; PG8_WAIT_L(0); PG8_MMA(1, 0, At, B0); PG8_BAR; PG8_SCHED;
            PG8_STAGE(PG8_SB(1, 1), b3 + hstep, voffB);
            PG8_WAIT_V(6); PG8_BAR; PG8_MMA(1, 1, At, B1); PG8_BAR;
        }
        PG8_STAMP();
        if constexpr (!Epi::AFTER_DRAIN) { E(acc, cur, wr, wc, fr, fq); S.done(cur); }
        PG8_STAMP();
        if (!has_next) break;
#pragma unroll
        for (int a = 0; a < 2; ++a)
#pragma unroll
            for (int b = 0; b < 2; ++b)
#pragma unroll
                for (int m = 0; m < 4; ++m)
#pragma unroll
                    for (int n = 0; n < 2; ++n) acc[a][b][m][n] = (f32x4){0.f, 0.f, 0.f, 0.f};
        cur = nxt; cA = nA; cB = nB; ++ui;
    }
    PG8_WAIT_V(0);
    if (wr == 0) PG8_BAR;
    PG8_BAR;
    if constexpr (Epi::AFTER_DRAIN) { E.fused(acc, cur, wr, wc, fr, fq, lds, wid, lane); S.done(cur); }
    PG8_STAMP();
    if (STAMP && wid == 0) { stamps[lane] = lane < nts ? (((unsigned long long)(unsigned)ts_hi << 32) | (unsigned)ts_lo) : 0ull;
        if (lane == 62) stamps[62] = rt_entry; if (lane == 63) stamps[63] = (unsigned long long)wall_clock64(); }
#undef PG8_STAMP
#undef PG8_SA
#undef PG8_SB
#undef PG8_STAGE
#undef PG8_LDA
#undef PG8_LDB
#undef PG8_MMA
#undef PG8_WAIT_V
#undef PG8_WAIT_L
#undef PG8_BAR
#undef PG8_SCHED
}
}
constexpr int T_ = 8192, D_ = 2048, DEPTH_ = 4, GW_ = 64, NROWS_ = 128;
constexpr int DC_ = 1024, DL_ = 1024, NZ_ = 5120;
constexpr float ALPHA_ = 1.681792830507429f;
constexpr float LN_EPS_ = 1e-5f;
typedef unsigned short bf16_t;

__device__ __forceinline__ bf16_t f2bf(float f) { unsigned u = __float_as_uint(f); u += 0x7FFFu + ((u >> 16) & 1u); return (bf16_t)(u >> 16); }
__device__ __forceinline__ float bf2f(bf16_t b) { return __uint_as_float(((unsigned)b) << 16); }
__device__ __forceinline__ float gelu_exact(float v) { return 0.5f * v * (1.0f + erff(v * 0.70710678118654752f)); }
__device__ __forceinline__ float sigmoidf_(float v) { return 1.0f / (1.0f + expf(-v)); }

__global__ void k_cvt_bf16(const float* __restrict__ in, bf16_t* __restrict__ out, size_t n) {
    for (size_t i = (size_t)blockIdx.x * blockDim.x + threadIdx.x; i < n; i += (size_t)gridDim.x * blockDim.x) out[i] = f2bf(in[i]);
}
__global__ void k_cvt_T(const float* __restrict__ in, bf16_t* __restrict__ out, int K, int N) {
    __shared__ float tile[64][65];
    const int n0 = blockIdx.x * 64, k0 = blockIdx.y * 64, tx = threadIdx.x & 63, ty = threadIdx.x >> 6;
    for (int i = 0; i < 16; ++i) { const int k = i * 4 + ty; tile[k][tx] = in[(size_t)(k0 + k) * N + n0 + tx]; }
    __syncthreads();
    for (int i = 0; i < 16; ++i) { const int n = i * 4 + ty; out[(size_t)(n0 + n) * K + k0 + tx] = f2bf(tile[tx][n]); }
}

template <class Epi> __global__ __launch_bounds__(512, 2) void k_gemm(pg8::Gemm g, Epi E) {
    extern __shared__ __attribute__((aligned(16))) unsigned char shm[];
    pg8::StaticOrder S; S.init(g.M, g.N, (int)gridDim.x, (int)blockIdx.x);
    pg8::gemm_phase<Epi, pg8::StaticOrder, false>((PG8_LAS unsigned char*)shm, g, S, E, nullptr);
}

__global__ void k_ln(const float* __restrict__ in, const float* __restrict__ gam, const float* __restrict__ bet, float* __restrict__ outf, bf16_t* __restrict__ outb) {
    __shared__ float red[8];
    const int t = blockIdx.x, tid = threadIdx.x;
    const float4* p = (const float4*)(in + (size_t)t * D_) + tid * 2;
    float4 a = p[0], b = p[1];
    float s = a.x + a.y + a.z + a.w + b.x + b.y + b.z + b.w;
    for (int o = 32; o >= 1; o >>= 1) s += __shfl_xor(s, o);
    if ((tid & 63) == 0) red[tid >> 6] = s;
    __syncthreads();
    const float mu = (red[0] + red[1] + red[2] + red[3]) * (1.0f / D_);
    float v[8] = {a.x - mu, a.y - mu, a.z - mu, a.w - mu, b.x - mu, b.y - mu, b.z - mu, b.w - mu};
    float q = 0.f;
#pragma unroll
    for (int i = 0; i < 8; ++i) q += v[i] * v[i];
    for (int o = 32; o >= 1; o >>= 1) q += __shfl_xor(q, o);
    if ((tid & 63) == 0) red[4 + (tid >> 6)] = q;
    __syncthreads();
    const float rstd = rsqrtf((red[4] + red[5] + red[6] + red[7]) * (1.0f / D_) + LN_EPS_);
    const int c0 = tid * 8;
#pragma unroll
    for (int i = 0; i < 8; ++i) { const float y = v[i] * rstd * gam[c0 + i] + bet[c0 + i]; outf[(size_t)t * D_ + c0 + i] = y; if (outb) outb[(size_t)t * D_ + c0 + i] = f2bf(y); }
}

__global__ void k_xc(const float* __restrict__ Z, const float* __restrict__ cw  , const float* __restrict__ cb  , float* __restrict__ XC) {
    const size_t idx = (size_t)blockIdx.x * blockDim.x + threadIdx.x;
    const int c = (int)(idx & 1023); const int t = (int)((idx >> 10) & (T_ - 1)); const int d = (int)(idx >> 23);
    float acc = cb[d * 1024 + c];
#pragma unroll
    for (int k = 0; k < 4; ++k) { const int tt = d == 0 ? t + k - 3 : t + k; if (tt >= 0 && tt < T_) acc += cw[(d * 4 + k) * 1024 + c] * Z[(size_t)tt * NZ_ + 4096 + c]; }
    XC[idx] = acc;
}
__global__ void k_gates(const float* __restrict__ XC, const float* __restrict__ wr  , const float* __restrict__ br, const float* __restrict__ wi, const float* __restrict__ bi,
                        const float* __restrict__ lam  , float* __restrict__ AA, float* __restrict__ UU) {
    const size_t idx = (size_t)blockIdx.x * blockDim.x + threadIdx.x;
    const int j = (int)(idx & 1023); const int t = (int)((idx >> 10) & (T_ - 1)); const int d = (int)(idx >> 23);
    const int h = j >> 7, jj = j & 127;
    const float* x = XC + ((size_t)d * T_ + t) * 1024 + h * 128;
    const float* pwr = wr + ((size_t)(d * 8 + h) * 128) * 128 + jj; const float* pwi = wi + ((size_t)(d * 8 + h) * 128) * 128 + jj;
    float r = br[d * 1024 + j], g = bi[d * 1024 + j];
    for (int i = 0; i < 128; ++i) { const float xv = x[i]; r += xv * pwr[(size_t)i * 128]; g += xv * pwi[(size_t)i * 128]; }
    r = sigmoidf_(r); g = sigmoidf_(g);
    const float sp = log1pf(expf(-lam[d * 1024 + j]));
    const float log_a = -8.0f * r * sp;
    const float a = expf(log_a);
    const float u = sqrtf(-expm1f(2.0f * log_a)) * g * x[jj];
    AA[idx] = a; UU[idx] = u;
}
__global__ void k_scan(const float* __restrict__ AA, float* __restrict__ UU) {
    const int id = blockIdx.x * blockDim.x + threadIdx.x;
    const int c = id & 1023, d = id >> 10;
    const float* a = AA + (size_t)d * T_ * 1024 + c; float* u = UU + (size_t)d * T_ * 1024 + c;
    float h = 0.f;
    if (d == 0) {
        for (int t = 0; t < T_; t += 8) { float av[8], uv[8];
#pragma unroll
            for (int k = 0; k < 8; ++k) { av[k] = a[(size_t)(t + k) * 1024]; uv[k] = u[(size_t)(t + k) * 1024]; }
#pragma unroll
            for (int k = 0; k < 8; ++k) { h = av[k] * h + uv[k]; u[(size_t)(t + k) * 1024] = h; } }
    } else {
        for (int t = T_ - 8; t >= 0; t -= 8) { float av[8], uv[8];
#pragma unroll
            for (int k = 0; k < 8; ++k) { av[k] = a[(size_t)(t + k) * 1024]; uv[k] = u[(size_t)(t + k) * 1024]; }
#pragma unroll
            for (int k = 7; k >= 0; --k) { h = av[k] * h + uv[k]; u[(size_t)(t + k) * 1024] = h; } }
    }
}
__global__ void k_even_out(const float* __restrict__ Z, const float* __restrict__ ca  , const float* __restrict__ H  , bf16_t* __restrict__ Y  ) {
    const size_t idx = (size_t)blockIdx.x * blockDim.x + threadIdx.x;
    const int c = (int)(idx & 1023); const int t = (int)(idx >> 10);
    float s = 0.f;
#pragma unroll
    for (int k = 0; k < 3; ++k) { const int tt = t + k - 1; if (tt >= 0 && tt < T_) s += ca[k * 1024 + c] * Z[(size_t)tt * NZ_ + 1024 + c] * Z[(size_t)tt * NZ_ + 2048 + c]; }
    const float ya = Z[(size_t)t * NZ_ + c] * s;
    const float hh = H[(size_t)t * 1024 + c] + H[((size_t)T_ + t) * 1024 + c];
    const float yb = gelu_exact(Z[(size_t)t * NZ_ + 3072 + c]) * hh;
    Y[(size_t)t * D_ + c] = f2bf(ya); Y[(size_t)t * D_ + 1024 + c] = f2bf(yb);
}

__global__ void k_attn_naive(const float* __restrict__ QKV, const float* __restrict__ rb, bf16_t* __restrict__ O) {
    __shared__ float qs[128]; __shared__ float ps[128]; __shared__ float red[4];
    const int t = blockIdx.x >> 4, h = blockIdx.x & 15, tid = threadIdx.x;
    const int r = t >> 6, c = t & 63;
    const int rs = min(max(r - 4, 0), NROWS_ - 8), cs = min(max(c - 8, 0), GW_ - 16);
    qs[tid] = QKV[(size_t)t * 6144 + h * 128 + tid];
    __syncthreads();
    const int kr = tid >> 4, kc = tid & 15;
    const int tk = (rs + kr) * 64 + cs + kc;
    const float* kp = QKV + (size_t)tk * 6144 + 2048 + h * 128;
    float s = 0.f;
    for (int d = 0; d < 128; ++d) s += qs[d] * kp[d];
    int co = (cs + kc) - c; co = min(max(co, -15), 15) + 15;
    const int ro = (rs + kr) - r + 7;
    s = s * 0.08838834764831845f + rb[(h * 15 + ro) * 31 + co];
    float m = s;
    for (int o = 32; o >= 1; o >>= 1) m = fmaxf(m, __shfl_xor(m, o));
    if ((tid & 63) == 0) red[tid >> 6] = m;
    __syncthreads();
    m = fmaxf(red[0], red[1]);
    const float p = expf(s - m);
    float l = p;
    for (int o = 32; o >= 1; o >>= 1) l += __shfl_xor(l, o);
    if ((tid & 63) == 0) red[2 + (tid >> 6)] = l;
    ps[tid] = p;
    __syncthreads();
    l = red[2] + red[3];
    float o = 0.f;
    for (int k = 0; k < 128; ++k) { const int tk2 = (rs + (k >> 4)) * 64 + cs + (k & 15); o += ps[k] * QKV[(size_t)tk2 * 6144 + 4096 + h * 128 + tid]; }
    O[(size_t)t * D_ + h * 128 + tid] = f2bf(o / l);
}

__global__ void k_peer_topk_naive(const float* __restrict__ Q, const float* __restrict__ sk, int* __restrict__ E, float* __restrict__ G) {
    __shared__ float q[2048]; __shared__ float s[16][128]; __shared__ float sv[16][16]; __shared__ int si[16][16]; __shared__ unsigned char used[8][256];
    const int t = blockIdx.x, tid = threadIdx.x;
    for (int i = tid; i < 2048; i += 256) q[i] = Q[(size_t)t * 2048 + i];
    for (int i = tid; i < 8 * 256; i += 256) ((unsigned char*)used)[i] = 0;
    __syncthreads();
    for (int o = tid; o < 2048; o += 256) { const int hp = o >> 7, k = o & 127, p = hp & 1; const float* kp = sk + ((size_t)p * 128 + k) * 128; const float* qp = q + hp * 128;
        float a = 0.f; for (int d = 0; d < 128; ++d) a += qp[d] * kp[d]; s[hp][k] = a; }
    __syncthreads();
    if (tid < 16) { const int hp = tid;
        for (int it = 0; it < 16; ++it) { float best = -INFINITY; int bi = 0;
            for (int k = 0; k < 128; ++k) { const float v = s[hp][k]; if (v > best) { best = v; bi = k; } }
            sv[hp][it] = best; si[hp][it] = bi; s[hp][bi] = -INFINITY; } }
    __syncthreads();
    if (tid < 8) { const int h = tid; float mx = -INFINITY;
        for (int it = 0; it < 16; ++it) { float best = -INFINITY; int bi = 0;
            for (int ci = 0; ci < 256; ++ci) { if (used[h][ci]) continue; const float v = sv[h * 2][ci >> 4] + sv[h * 2 + 1][ci & 15]; if (v > best) { best = v; bi = ci; } }
            used[h][bi] = 1;
            E[(size_t)t * 128 + h * 16 + it] = si[h * 2][bi >> 4] * 128 + si[h * 2 + 1][bi & 15];
            G[(size_t)t * 128 + h * 16 + it] = best;
            if (it == 0) mx = best; }
        float sum = 0.f;
        for (int it = 0; it < 16; ++it) { const float e = expf(G[(size_t)t * 128 + h * 16 + it] - mx); sum += e; G[(size_t)t * 128 + h * 16 + it] = e; }
        const float inv = 1.0f / sum;
        for (int it = 0; it < 16; ++it) G[(size_t)t * 128 + h * 16 + it] *= inv; }
}
__global__ void k_peer_gather_naive(const float* __restrict__ X1, const float* __restrict__ U, const float* __restrict__ V, const int* __restrict__ E, const float* __restrict__ G, float* __restrict__ PRE) {
    __shared__ float wgt[128]; __shared__ int es[128];
    const int t = blockIdx.x, tid = threadIdx.x, lane = tid & 63, w = tid >> 6;
    if (tid < 128) es[tid] = E[(size_t)t * 128 + tid];
    float4 xr[8];
#pragma unroll
    for (int i = 0; i < 8; ++i) xr[i] = *(const float4*)(X1 + (size_t)t * D_ + i * 256 + lane * 4);
    __syncthreads();
    for (int sl = w * 32; sl < w * 32 + 32; ++sl) { const float* up = U + (size_t)es[sl] * D_; float a = 0.f;
#pragma unroll
        for (int i = 0; i < 8; ++i) { const float4 uv = *(const float4*)(up + i * 256 + lane * 4); a += xr[i].x * uv.x + xr[i].y * uv.y + xr[i].z * uv.z + xr[i].w * uv.w; }
        for (int o = 32; o >= 1; o >>= 1) a += __shfl_xor(a, o);
        if (lane == 0) wgt[sl] = gelu_exact(a) * G[(size_t)t * 128 + sl]; }
    __syncthreads();
    float4 y0 = {0.f, 0.f, 0.f, 0.f}, y1 = {0.f, 0.f, 0.f, 0.f};
    for (int sl = 0; sl < 128; ++sl) { const float* vp = V + (size_t)es[sl] * D_ + tid * 8; const float wv = wgt[sl]; const float4 a = *(const float4*)vp, b = *(const float4*)(vp + 4);
        y0.x += wv * a.x; y0.y += wv * a.y; y0.z += wv * a.z; y0.w += wv * a.w; y1.x += wv * b.x; y1.y += wv * b.y; y1.z += wv * b.z; y1.w += wv * b.w; }
    const float* xp = X1 + (size_t)t * D_ + tid * 8; float* pp = PRE + (size_t)t * D_ + tid * 8;
    const float4 xa = *(const float4*)xp, xb = *(const float4*)(xp + 4);
    *(float4*)pp = make_float4(ALPHA_ * xa.x + y0.x, ALPHA_ * xa.y + y0.y, ALPHA_ * xa.z + y0.z, ALPHA_ * xa.w + y0.w);
    *(float4*)(pp + 4) = make_float4(ALPHA_ * xb.x + y1.x, ALPHA_ * xb.y + y1.y, ALPHA_ * xb.z + y1.z, ALPHA_ * xb.w + y1.w);
}
struct WsAlloc { char* base; size_t off; void* get(size_t bytes) { void* p = base + off; off += (bytes + 255) & ~(size_t)255; return p; } };

template <class Epi> static void launch_gemm(const pg8::Gemm& g, const Epi& E, hipStream_t st) {
    static bool attr = false; if (!attr) { (void)hipFuncSetAttribute((const void*)k_gemm<Epi>, hipFuncAttributeMaxDynamicSharedMemorySize, pg8::STAGE_BYTES); attr = true; }
    hipLaunchKernelGGL((k_gemm<Epi>), dim3(256), dim3(512), pg8::STAGE_BYTES, st, g, E);
}

extern "C" void kernel_launch(void* const* d_in, const int* in_sizes, int n_in, void* d_out, int out_size, void* d_ws, size_t ws_size, hipStream_t stream) {
    const float* x = (const float*)d_in[0];
    const float* ev_w_in = (const float*)d_in[1];   const float* ev_conv_a = (const float*)d_in[2];
    const float* ev_conv_b_w = (const float*)d_in[3]; const float* ev_conv_b_b = (const float*)d_in[4];
    const float* ev_w_r = (const float*)d_in[5];    const float* ev_b_r = (const float*)d_in[6];
    const float* ev_w_i = (const float*)d_in[7];    const float* ev_b_i = (const float*)d_in[8];
    const float* ev_lam = (const float*)d_in[9];    const float* ev_w_out = (const float*)d_in[10];
    const float* od_w_qkv = (const float*)d_in[11]; const float* od_rel_bias = (const float*)d_in[12];
    const float* od_w_o = (const float*)d_in[13];   const float* pk_w_q = (const float*)d_in[14];
    const float* pk_sub_keys = (const float*)d_in[15]; const float* pk_u = (const float*)d_in[16]; const float* pk_v = (const float*)d_in[17];
    const float* ln1_g = (const float*)d_in[18];    const float* ln1_b = (const float*)d_in[19];
    const float* ln2_g = (const float*)d_in[20];    const float* ln2_b = (const float*)d_in[21];
    float* out = (float*)d_out;

    WsAlloc W{(char*)d_ws, 0};
    const size_t TD = (size_t)T_ * D_;
    bf16_t* xb  = (bf16_t*)W.get(TD * 2);
    float*  x1f = (float*)W.get(TD * 4);
    bf16_t* x1b = (bf16_t*)W.get(TD * 2);
    float*  x2f = (float*)W.get(TD * 4);
    float*  pre = (float*)W.get(TD * 4);
    float*  Z   = (float*)W.get((size_t)T_ * 6144 * 4);
    bf16_t* Yb  = (bf16_t*)W.get(TD * 2);
    bf16_t* WinT  = (bf16_t*)W.get((size_t)2 * 5120 * 2048 * 2);
    bf16_t* WoutT = (bf16_t*)W.get((size_t)2 * 2048 * 2048 * 2);
    bf16_t* WqkvT = (bf16_t*)W.get((size_t)2 * 6144 * 2048 * 2);
    bf16_t* WoT   = (bf16_t*)W.get((size_t)2 * 2048 * 2048 * 2);
    bf16_t* WqT   = (bf16_t*)W.get((size_t)4 * 2048 * 2048 * 2);
    float*  XC = (float*)W.get((size_t)2 * T_ * 1024 * 4);
    float*  AA = (float*)W.get((size_t)2 * T_ * 1024 * 4);
    float*  UU = (float*)W.get((size_t)2 * T_ * 1024 * 4);
    int*    Eb = (int*)W.get((size_t)T_ * 128 * 4);
    float*  Gb = (float*)W.get((size_t)T_ * 128 * 4);

    hipLaunchKernelGGL(k_cvt_bf16, dim3(2048), dim3(256), 0, stream, x, xb, TD);
    for (int i = 0; i < 2; ++i) {
        hipLaunchKernelGGL(k_cvt_T, dim3(5120 / 64, 2048 / 64), dim3(256), 0, stream, ev_w_in + (size_t)i * 2048 * 5120, WinT + (size_t)i * 5120 * 2048, 2048, 5120);
        hipLaunchKernelGGL(k_cvt_T, dim3(2048 / 64, 2048 / 64), dim3(256), 0, stream, ev_w_out + (size_t)i * 2048 * 2048, WoutT + (size_t)i * 2048 * 2048, 2048, 2048);
        hipLaunchKernelGGL(k_cvt_T, dim3(6144 / 64, 2048 / 64), dim3(256), 0, stream, od_w_qkv + (size_t)i * 2048 * 6144, WqkvT + (size_t)i * 6144 * 2048, 2048, 6144);
        hipLaunchKernelGGL(k_cvt_T, dim3(2048 / 64, 2048 / 64), dim3(256), 0, stream, od_w_o + (size_t)i * 2048 * 2048, WoT + (size_t)i * 2048 * 2048, 2048, 2048);
    }
    for (int l = 0; l < 4; ++l)
        hipLaunchKernelGGL(k_cvt_T, dim3(2048 / 64, 2048 / 64), dim3(256), 0, stream, pk_w_q + (size_t)l * 2048 * 2048, WqT + (size_t)l * 2048 * 2048, 2048, 2048);

    const float* xin_f = x; const bf16_t* xin_b = xb;
    for (int l = 0; l < 4; ++l) {
        const int i = l >> 1;
        if ((l & 1) == 0) {
            pg8::Gemm g{xin_b, WinT + (size_t)i * 5120 * 2048, T_, 5120, 2048, 0};
            pg8::EpiF32 e{Z, nullptr, 5120, 0};
            launch_gemm(g, e, stream);
            hipLaunchKernelGGL(k_xc, dim3(2 * T_ * 1024 / 256), dim3(256), 0, stream, Z, ev_conv_b_w + (size_t)i * 2 * 4 * 1024, ev_conv_b_b + (size_t)i * 2 * 1024, XC);
            hipLaunchKernelGGL(k_gates, dim3(2 * T_ * 1024 / 256), dim3(256), 0, stream, XC, ev_w_r + (size_t)i * 2 * 8 * 128 * 128, ev_b_r + (size_t)i * 2048,
                               ev_w_i + (size_t)i * 2 * 8 * 128 * 128, ev_b_i + (size_t)i * 2048, ev_lam + (size_t)i * 2048, AA, UU);
            hipLaunchKernelGGL(k_scan, dim3(8), dim3(256), 0, stream, AA, UU);
            hipLaunchKernelGGL(k_even_out, dim3(T_ * 1024 / 256), dim3(256), 0, stream, Z, ev_conv_a + (size_t)i * 3 * 1024, UU, Yb);
            pg8::Gemm g2{Yb, WoutT + (size_t)i * 2048 * 2048, T_, 2048, 2048, 0};
            pg8::EpiRes e2{pre, xin_f, 2048, ALPHA_};
            launch_gemm(g2, e2, stream);
        } else {
            pg8::Gemm g{xin_b, WqkvT + (size_t)i * 6144 * 2048, T_, 6144, 2048, 0};
            pg8::EpiF32 e{Z, nullptr, 6144, 0};
            launch_gemm(g, e, stream);
            hipLaunchKernelGGL(k_attn_naive, dim3(T_ * 16), dim3(128), 0, stream, Z, od_rel_bias + (size_t)i * 16 * 15 * 31, Yb);
            pg8::Gemm g2{Yb, WoT + (size_t)i * 2048 * 2048, T_, 2048, 2048, 0};
            pg8::EpiRes e2{pre, xin_f, 2048, ALPHA_};
            launch_gemm(g2, e2, stream);
        }
        hipLaunchKernelGGL(k_ln, dim3(T_), dim3(256), 0, stream, pre, ln1_g + (size_t)l * D_, ln1_b + (size_t)l * D_, x1f, x1b);
        pg8::Gemm gq{x1b, WqT + (size_t)l * 2048 * 2048, T_, 2048, 2048, 0};
        pg8::EpiF32 eq{Z, nullptr, 2048, 0};
        launch_gemm(gq, eq, stream);
        hipLaunchKernelGGL(k_peer_topk_naive, dim3(T_), dim3(256), 0, stream, Z, pk_sub_keys + (size_t)l * 2 * 128 * 128, Eb, Gb);
        hipLaunchKernelGGL(k_peer_gather_naive, dim3(T_), dim3(256), 0, stream, x1f, pk_u + (size_t)l * 16384 * 2048, pk_v + (size_t)l * 16384 * 2048, Eb, Gb, pre);
        float* of = (l == 3) ? out : x2f;
        hipLaunchKernelGGL(k_ln, dim3(T_), dim3(256), 0, stream, pre, ln2_g + (size_t)l * D_, ln2_b + (size_t)l * D_, of, (l == 3) ? (bf16_t*)nullptr : xb);
        xin_f = x2f; xin_b = xb;
    }
}
```

```cpp
#include <hip/hip_runtime.h>
#include <stdint.h>
#include <string.h>
#include <math.h>
namespace pg8 {
#define PG8_LAS __attribute__((address_space(3)))
typedef unsigned short bf16_t;
typedef short bf16x8 __attribute__((ext_vector_type(8)));
typedef float f32x4 __attribute__((ext_vector_type(4)));
typedef unsigned u32x4 __attribute__((ext_vector_type(4)));
constexpr int BM = 256, BK = 64, HALF = 128, HTB = HALF * BK * 2  , STAGE_BYTES = 8 * HTB, NXCD = 8, WGM = 8;

__host__ __device__ __forceinline__ int lds_byte(int r, int c) { const int st = (r >> 4) * 2 + (c >> 5), rr = r & 15, cc = c & 31, ob = rr * 64 + cc * 2; return st * 1024 + (ob ^ (((ob >> 9) & 1) << 5)); }
__host__ __device__ __forceinline__ void stage_rc(int b, int& R, int& C) { const int st = b / 1024, sb = b % 1024, swz = sb ^ (((sb >> 9) & 1) << 5); R = (st >> 1) * 16 + swz / 64; C = (st & 1) * 32 + (swz % 64) / 2; }
__host__ __device__ __forceinline__ int perm32(int rho) { const int n = rho >> 4, i = rho & 15; return 8 * (i >> 2) + 4 * n + (i & 3); }

struct Unit { int pm, pn; };
struct Gemm { const bf16_t* A; const bf16_t* Bt; int M, N, K, pad_; };

struct StaticOrder {
    int nM, nN, nwg, G, c;
    __host__ __device__ void init(int M, int N, int G_, int c_) { nM = M / BM; nN = N / BM; nwg = nM * nN; G = G_; c = c_; }
    __host__ __device__ bool next(int i, Unit& u) const {
        const long L = (long)i * G + c; if (L >= nwg) return false;
        int wgid = (int)L; { const int q = nwg / NXCD, r = nwg % NXCD, xcd = wgid % NXCD, off = wgid / NXCD; wgid = (xcd < r ? xcd * (q + 1) : r * (q + 1) + (xcd - r) * q) + off; }
        const int nig = WGM * nN, gid = wgid / nig, fm = gid * WGM, gsz = (nM - fm) < WGM ? (nM - fm) : WGM;
        u.pm = fm + ((wgid % nig) % gsz); u.pn = (wgid % nig) / gsz; return true;
    }
    __device__ __forceinline__ void a_ready(const Unit&) const {}
    __device__ __forceinline__ void done(const Unit&) const {}
};
struct CountedOrder : StaticOrder {
    const unsigned* ready; unsigned need; unsigned* tmo;
    __device__ __forceinline__ void a_ready(const Unit& u) const {
        if (threadIdx.x < 64) {
            const unsigned long long t0 = __builtin_amdgcn_s_memrealtime(); unsigned polls = 0;
            while ((unsigned)__builtin_amdgcn_readfirstlane(__hip_atomic_load(ready + 64 * u.pm, __ATOMIC_RELAXED, __HIP_MEMORY_SCOPE_AGENT)) < need) {
                if ((++polls & 255u) == 0u && __builtin_amdgcn_readfirstlane(__hip_atomic_load(tmo, __ATOMIC_RELAXED, __HIP_MEMORY_SCOPE_AGENT)) != 0u) break;
                if (__builtin_amdgcn_s_memrealtime() - t0 > 2000000ull) {
                    if (threadIdx.x == 0) { unsigned expect = 0u; __hip_atomic_compare_exchange_strong(tmo + 1, &expect, 0x600u | (unsigned)(u.pm & 0xff), __ATOMIC_RELAXED, __ATOMIC_RELAXED, __HIP_MEMORY_SCOPE_AGENT); __hip_atomic_store(tmo, 1u, __ATOMIC_RELAXED, __HIP_MEMORY_SCOPE_AGENT); }
                    break; }
                __builtin_amdgcn_s_sleep(2); }
            __builtin_amdgcn_fence(__ATOMIC_ACQUIRE, "agent");
            asm volatile("s_waitcnt vmcnt(0)" ::: "memory");
        }
#if !defined(BROKEN_HOOK_NO_BARRIER)
        asm volatile("" ::: "memory"); __builtin_amdgcn_s_barrier(); asm volatile("" ::: "memory");
#endif
    }
};

__device__ __forceinline__ unsigned cvt_pk_bf16(float lo, float hi) { unsigned r; asm volatile("v_cvt_pk_bf16_f32 %0, %1, %2" : "=v"(r) : "v"(lo), "v"(hi)); return r; }
typedef float f32x2 __attribute__((ext_vector_type(2)));
__device__ __forceinline__ f32x2 gelu_pk(f32x2 v) {
    const f32x2 av = __builtin_elementwise_abs(v), d = av * 0.2316418882f + 1.0f;
    f32x2 t; t.x = __builtin_amdgcn_rcpf(d.x); t.y = __builtin_amdgcn_rcpf(d.y);
    f32x2 q = t * 0.5307027145f + (-0.7265760135f); q = q * t + 0.7107068705f; q = q * t + (-0.142248368f); q = q * t + 0.127414796f; q = q * t;
    const f32x2 s = (v * v) * (-0.72134752044f);
    f32x2 e; e.x = __builtin_amdgcn_exp2f(s.x); e.y = __builtin_amdgcn_exp2f(s.y);
    const f32x2 m = v * (q * e), r = v - m;
    f32x2 o; o.x = v.x < 0.f ? m.x : r.x; o.y = v.y < 0.f ? m.y : r.y; return o;
}

struct EpiF32 {
    static constexpr bool PERM = false, AFTER_DRAIN = false;
    float* C; const float* bias; int ldc; int pad_;
    __device__ __forceinline__ void operator()(const f32x4 (&acc)[2][2][4][2], const Unit& u, int wr, int wc, int fr, int fq) const {
        const int row0 = u.pm * BM + wr * 64 + fr, col0 = u.pn * BM + wc * 32 + 4 * fq;
        f32x4 bv[2][2];
#pragma unroll
        for (int bj = 0; bj < 2; ++bj)
#pragma unroll
            for (int n = 0; n < 2; ++n) bv[bj][n] = bias ? *(const f32x4*)(bias + col0 + bj * HALF + n * 16) : (f32x4){0.f, 0.f, 0.f, 0.f};
#pragma unroll
        for (int ai = 0; ai < 2; ++ai)
#pragma unroll
            for (int m = 0; m < 4; ++m) { float* rowp = C + (size_t)(row0 + ai * HALF + m * 16) * ldc + col0;
#pragma unroll
                for (int bj = 0; bj < 2; ++bj)
#pragma unroll
                    for (int n = 0; n < 2; ++n) *(f32x4*)(rowp + bj * HALF + n * 16) = acc[ai][bj][m][n] + bv[bj][n]; }
    }
};
template <int ACT  > struct EpiBf16 {
    static constexpr bool PERM = true, AFTER_DRAIN = false;
    bf16_t* O; const float* bias; size_t split_stride; int ldc; int split_cols;
    __device__ __forceinline__ void operator()(const f32x4 (&acc)[2][2][4][2], const Unit& u, int wr, int wc, int fr, int fq) const {
        const int row0 = u.pm * BM + wr * 64 + fr; int colt = u.pn * BM; bf16_t* base = O;
        if (split_cols) { const int t = colt / split_cols; base += (size_t)t * split_stride; colt -= t * split_cols; }
        const int col0 = colt + wc * 32 + 8 * fq, bcol0 = u.pn * BM + wc * 32 + 8 * fq;
        f32x4 bv[2][2];
#pragma unroll
        for (int bj = 0; bj < 2; ++bj)
#pragma unroll
            for (int n = 0; n < 2; ++n) bv[bj][n] = bias ? *(const f32x4*)(bias + bcol0 + bj * HALF + 4 * n) : (f32x4){0.f, 0.f, 0.f, 0.f};
#pragma unroll
        for (int ai = 0; ai < 2; ++ai)
#pragma unroll
            for (int m = 0; m < 4; ++m) { bf16_t* rowp = base + (size_t)(row0 + ai * HALF + m * 16) * ldc + col0;
#pragma unroll
                for (int bj = 0; bj < 2; ++bj) { f32x4 v0 = acc[ai][bj][m][0] + bv[bj][0], v1 = acc[ai][bj][m][1] + bv[bj][1];
                    if (ACT == 1) { f32x2 a = gelu_pk((f32x2){v0[0], v0[1]}), b = gelu_pk((f32x2){v0[2], v0[3]}), c = gelu_pk((f32x2){v1[0], v1[1]}), d = gelu_pk((f32x2){v1[2], v1[3]});
                        v0 = (f32x4){a.x, a.y, b.x, b.y}; v1 = (f32x4){c.x, c.y, d.x, d.y}; }
                    if (ACT == 2) {
#pragma unroll
                        for (int j = 0; j < 4; ++j) { v0[j] = 0.5f * v0[j] * (1.0f + erff(v0[j] * 0.70710678f)); v1[j] = 0.5f * v1[j] * (1.0f + erff(v1[j] * 0.70710678f)); } }
                    u32x4 w; w.x = cvt_pk_bf16(v0[0], v0[1]); w.y = cvt_pk_bf16(v0[2], v0[3]); w.z = cvt_pk_bf16(v1[0], v1[1]); w.w = cvt_pk_bf16(v1[2], v1[3]);
                    *(u32x4*)(rowp + bj * HALF) = w; } }
    }
};
struct EpiResB16 {
    static constexpr bool PERM = true, AFTER_DRAIN = false;
    bf16_t* O; const bf16_t* X; int ldc; float alpha;
    __device__ __forceinline__ void operator()(const f32x4 (&acc)[2][2][4][2], const Unit& u, int wr, int wc, int fr, int fq) const {
        const int row0 = u.pm * BM + wr * 64 + fr, col0 = u.pn * BM + wc * 32 + 8 * fq;
#pragma unroll
        for (int ai = 0; ai < 2; ++ai)
#pragma unroll
            for (int m = 0; m < 4; ++m) { const size_t ro = (size_t)(row0 + ai * HALF + m * 16) * ldc + col0;
#pragma unroll
                for (int bj = 0; bj < 2; ++bj) { const u32x4 xb = *(const u32x4*)(X + ro + bj * HALF);
                    const f32x4 v0 = acc[ai][bj][m][0], v1 = acc[ai][bj][m][1];
                    u32x4 w;
                    w.x = cvt_pk_bf16(v0[0] + alpha * __uint_as_float(xb.x << 16), v0[1] + alpha * __uint_as_float(xb.x & 0xffff0000u));
                    w.y = cvt_pk_bf16(v0[2] + alpha * __uint_as_float(xb.y << 16), v0[3] + alpha * __uint_as_float(xb.y & 0xffff0000u));
                    w.z = cvt_pk_bf16(v1[0] + alpha * __uint_as_float(xb.z << 16), v1[1] + alpha * __uint_as_float(xb.z & 0xffff0000u));
                    w.w = cvt_pk_bf16(v1[2] + alpha * __uint_as_float(xb.w << 16), v1[3] + alpha * __uint_as_float(xb.w & 0xffff0000u));
                    *(u32x4*)(O + ro + bj * HALF) = w; } }
    }
};

struct EpiI8Bf16 {
    static constexpr bool PERM = true, AFTER_DRAIN = false;
    bf16_t* O; const float* rs; const float* cs; size_t ldc;
    __device__ __forceinline__ void operator()(const f32x4 (&acc)[2][2][4][2], const Unit& u, int wr, int wc, int fr, int fq) const {
        const int row0 = u.pm * BM + wr * 64 + fr, col0 = u.pn * BM + wc * 32 + 8 * fq;
        f32x4 cv[2][2];
#pragma unroll
        for (int bj = 0; bj < 2; ++bj)
#pragma unroll
            for (int n = 0; n < 2; ++n) cv[bj][n] = *(const f32x4*)(cs + col0 + bj * HALF + 4 * n);
#pragma unroll
        for (int ai = 0; ai < 2; ++ai)
#pragma unroll
            for (int m = 0; m < 4; ++m) { const int row = row0 + ai * HALF + m * 16; const float r = rs[row]; bf16_t* rowp = O + (size_t)row * ldc + col0;
#pragma unroll
                for (int bj = 0; bj < 2; ++bj) { f32x4 v0, v1;
#pragma unroll
                    for (int j = 0; j < 4; ++j) { v0[j] = (float)__float_as_int(acc[ai][bj][m][0][j]) * (r * cv[bj][0][j]); v1[j] = (float)__float_as_int(acc[ai][bj][m][1][j]) * (r * cv[bj][1][j]); }
                    u32x4 w; w.x = cvt_pk_bf16(v0[0], v0[1]); w.y = cvt_pk_bf16(v0[2], v0[3]); w.z = cvt_pk_bf16(v1[0], v1[1]); w.w = cvt_pk_bf16(v1[2], v1[3]);
                    *(u32x4*)(rowp + bj * HALF) = w; } }
    }
};

template <bool I8> __device__ __forceinline__ f32x4 mma16(const bf16x8 a, const bf16x8 b, const f32x4 c) {
    if constexpr (I8) { typedef int i32x4_ __attribute__((ext_vector_type(4)));
        return __builtin_bit_cast(f32x4, __builtin_amdgcn_mfma_i32_16x16x64_i8(__builtin_bit_cast(i32x4_, a), __builtin_bit_cast(i32x4_, b), __builtin_bit_cast(i32x4_, c), 0, 0, 0)); }
    else return __builtin_amdgcn_mfma_f32_16x16x32_bf16(a, b, c, 0, 0, 0);
}
template <class Epi, class Sched, bool STAMP = false, bool I8 = false>
__device__ __forceinline__ void gemm_phase(PG8_LAS unsigned char* lds, const Gemm g, const Sched& S, const Epi& E, unsigned long long* stamps) {
    int tid_ = threadIdx.x; asm volatile("" : "+v"(tid_));
    const int tid = tid_, wid = __builtin_amdgcn_readfirstlane(tid >> 6), lane = tid & 63, wr = wid >> 2, wc = wid & 3, fr = lane & 15, fq = lane >> 4;
    const int K = g.K, nt = K / BK;
    int ts_lo = 0, ts_hi = 0, nts = 0; const unsigned long long rt_entry = STAMP ? (unsigned long long)wall_clock64() : 0ull;
#define PG8_STAMP() do { if (STAMP && wid == 0 && nts < 64) { const unsigned long long _c = (unsigned long long)clock64(); \
        ts_lo = (lane == nts) ? (int)(unsigned)_c : ts_lo; ts_hi = (lane == nts) ? (int)(unsigned)(_c >> 32) : ts_hi; ++nts; } } while (0)
    PG8_STAMP();
    unsigned voffA[2], voffB[2];
#pragma unroll
    for (int i = 0; i < 2; ++i) { int R, C; stage_rc(tid * 16 + i * 8192, R, C); const int Rb = Epi::PERM ? ((R & ~31) + perm32(R & 31)) : R;
        voffA[i] = (unsigned)(R * K + C) * 2u; voffB[i] = (unsigned)(Rb * K + C) * 2u; }
    const size_t kstep = (size_t)(BK * 2);
    const size_t hstep = (size_t)HALF * K * 2;
    const size_t tstep = 2 * hstep;
    const unsigned ldsw = (unsigned)wid * 1024u;
    const int aoff = lds_byte(wr * 64 + fr, fq * 8), boff = lds_byte(wc * 32 + fr, fq * 8);
#define PG8_SA(b, h) (((b) * 2 + (h)) * HTB)
#define PG8_SB(b, h) ((4 + (b) * 2 + (h)) * HTB)
#define PG8_STAGE(bufoff, gbase, voff) do { _Pragma("unroll") for (int _i = 0; _i < 2; ++_i) \
        __builtin_amdgcn_global_load_lds((const unsigned*)((const char*)(gbase) + (voff)[_i]), (PG8_LAS unsigned*)(lds + (bufoff) + ldsw + _i * 8192), 16, 0, 0); } while (0)
#define PG8_LDA(dst, b, h) do { _Pragma("unroll") for (int m = 0; m < 4; ++m) _Pragma("unroll") for (int k = 0; k < 2; ++k) dst[m][k] = *(const PG8_LAS bf16x8*)(lds + PG8_SA(b, h) + aoff + m * 2048 + k * 1024); } while (0)
#define PG8_LDB(dst, b, h) do { _Pragma("unroll") for (int n = 0; n < 2; ++n) _Pragma("unroll") for (int k = 0; k < 2; ++k) dst[n][k] = *(const PG8_LAS bf16x8*)(lds + PG8_SB(b, h) + boff + n * 2048 + k * 1024); } while (0)
#define PG8_MMA(ai, bj, At, Bt) do { __builtin_amdgcn_s_setprio(1); _Pragma("unroll") for (int m = 0; m < 4; ++m) _Pragma("unroll") for (int n = 0; n < 2; ++n) _Pragma("unroll") for (int k = 0; k < 2; ++k) \
        acc[ai][bj][m][n] = mma16<I8>(Bt[n][k], At[m][k], acc[ai][bj][m][n]); __builtin_amdgcn_s_setprio(0); } while (0)
#define PG8_WAIT_V(n) asm volatile("s_waitcnt vmcnt(" #n ")" ::: "memory")
#define PG8_WAIT_L(n) asm volatile("s_waitcnt lgkmcnt(" #n ")" ::: "memory")
#define PG8_BAR __builtin_amdgcn_s_barrier()
#define PG8_SCHED __builtin_amdgcn_sched_barrier(0)
    Unit cur, nxt; int ui = 0;
    if (!S.next(0, cur)) return;
    f32x4 acc[2][2][4][2];
#pragma unroll
    for (int a = 0; a < 2; ++a)
#pragma unroll
        for (int b = 0; b < 2; ++b)
#pragma unroll
            for (int m = 0; m < 4; ++m)
#pragma unroll
                for (int n = 0; n < 2; ++n) acc[a][b][m][n] = (f32x4){0.f, 0.f, 0.f, 0.f};
    bf16x8 At[4][2], B0[2][2], B1[2][2];
    const char* cA = (const char*)g.A + (size_t)cur.pm * tstep; const char* cB = (const char*)g.Bt + (size_t)cur.pn * tstep;
    S.a_ready(cur);
    PG8_STAGE(PG8_SB(0, 0), cB, voffB); PG8_STAGE(PG8_SA(0, 0), cA, voffA); PG8_STAGE(PG8_SB(0, 1), cB + hstep, voffB); PG8_STAGE(PG8_SA(0, 1), cA + hstep, voffA);
    if (wr == 1) PG8_BAR;
    PG8_WAIT_V(4); PG8_BAR;
    PG8_STAGE(PG8_SB(1, 0), cB + kstep, voffB); PG8_STAGE(PG8_SA(1, 0), cA + kstep, voffA); PG8_STAGE(PG8_SB(1, 1), cB + hstep + kstep, voffB);
    PG8_WAIT_V(6); PG8_BAR;
    PG8_STAMP();
    for (;;) {
        const bool has_next = S.next(ui + 1, nxt);
        const char* nA = has_next ? (const char*)g.A + (size_t)nxt.pm * tstep : cA; const char* nB = has_next ? (const char*)g.Bt + (size_t)nxt.pn * tstep : cB;
        for (int t = 0; t < nt; t += 2) {
            const bool last = (t == nt - 2);
            const char* a1 = cA + (size_t)(t + 1) * kstep;
            const char* a2 = last ? nA : cA + (size_t)(t + 2) * kstep; const char* b2 = last ? nB : cB + (size_t)(t + 2) * kstep;
            const char* a3 = a2 + kstep; const char* b3 = b2 + kstep;
            if (last && has_next) S.a_ready(nxt);
            PG8_LDB(B0, 0, 0); PG8_SCHED; PG8_LDA(At, 0, 0); PG8_STAGE(PG8_SA(1, 1), a1 + hstep, voffA);
            PG8_WAIT_L(8); PG8_BAR; PG8_WAIT_L(0); PG8_MMA(0, 0, At, B0); PG8_BAR; PG8_SCHED;
            PG8_LDB(B1, 0, 1); PG8_STAGE(PG8_SB(0, 0), b2, voffB);
            PG8_BAR; PG8_WAIT_L(0); PG8_MMA(0, 1, At, B1); PG8_BAR;
            PG8_LDA(At, 0, 1); PG8_STAGE(PG8_SA(0, 0), a2, voffA);
            PG8_BAR; PG8_WAIT_L(0); PG8_MMA(1, 0, At, B0); PG8_BAR; PG8_SCHED;
            PG8_STAGE(PG8_SB(0, 1), b2 + hstep, voffB);
            PG8_WAIT_V(6); PG8_BAR; PG8_MMA(1, 1, At, B1); PG8_BAR;
            PG8_LDB(B0, 1, 0); PG8_SCHED; PG8_LDA(At, 1, 0); PG8_STAGE(PG8_SA(0, 1), a2 + hstep, voffA);
            PG8_WAIT_L(8); PG8_BAR; PG8_WAIT_L(0); PG8_MMA(0, 0, At, B0); PG8_BAR; PG8_SCHED;
            PG8_LDB(B1, 1, 1); PG8_STAGE(PG8_SB(1, 0), b3, voffB);
            PG8_BAR; PG8_WAIT_L(0); PG8_MMA(0, 1, At, B1); PG8_BAR;
            PG8_LDA(At, 1, 1); PG8_STAGE(PG8_SA(1, 0), a3, voffA);
            PG8_BAR; PG8_WAIT_L(0); PG8_MMA(1, 0, At, B0); PG8_BAR; PG8_SCHED;
            PG8_STAGE(PG8_SB(1, 1), b3 + hstep, voffB);
            PG8_WAIT_V(6); PG8_BAR; PG8_MMA(1, 1, At, B1); PG8_BAR;
        }
        PG8_STAMP();
        if constexpr (!Epi::AFTER_DRAIN) { E(acc, cur, wr, wc, fr, fq); S.done(cur); }
        PG8_STAMP();
        if (!has_next) break;
#pragma unroll
        for (int a = 0; a < 2; ++a)
#pragma unroll
            for (int b = 0; b < 2; ++b)
#pragma unroll
                for (int m = 0; m < 4; ++m)
#pragma unroll
                    for (int n = 0; n < 2; ++n) acc[a][b][m][n] = (f32x4){0.f, 0.f, 0.f, 0.f};
        cur = nxt; cA = nA; cB = nB; ++ui;
    }
    PG8_WAIT_V(0);
    if (wr == 0) PG8_BAR;
    PG8_BAR;
    if constexpr (Epi::AFTER_DRAIN) { E.fused(acc, cur, wr, wc, fr, fq, lds, wid, lane); S.done(cur); }
    PG8_STAMP();
    if (STAMP && wid == 0) { stamps[lane] = lane < nts ? (((unsigned long long)(unsigned)ts_hi << 32) | (unsigned)ts_lo) : 0ull;
        if (lane == 62) stamps[62] = rt_entry; if (lane == 63) stamps[63] = (unsigned long long)wall_clock64(); }
#undef PG8_STAMP
#undef PG8_SA
#undef PG8_SB
#undef PG8_STAGE
#undef PG8_LDA
#undef PG8_LDB
#undef PG8_MMA
#undef PG8_WAIT_V
#undef PG8_WAIT_L
#undef PG8_BAR
#undef PG8_SCHED
}
}
#define XB_TMO      128
#define XB_XCNT(j)  (256  + 64 * (j))
#define XB_XSUB(j)  (1280 + 64 * (j))
#define XB_XGEN(j)  (2304 + 64 * (j))
#define XB_TOP      3328
#define XB_TOPGEN   3392
#define XCD_BAR_WORDS 3456
#define XB_SPIN_CAP (1u << 18)
#define LAS __attribute__((address_space(3)))

__device__ __forceinline__ unsigned xb_ld(unsigned* p)              { return __hip_atomic_load(p, __ATOMIC_RELAXED, __HIP_MEMORY_SCOPE_AGENT); }
__device__ __forceinline__ unsigned xb_add(unsigned* p, unsigned v) { return __hip_atomic_fetch_add(p, v, __ATOMIC_RELAXED, __HIP_MEMORY_SCOPE_AGENT); }
__device__ __forceinline__ unsigned xb_xcc_id() { return (unsigned)__builtin_amdgcn_s_getreg((3 << 11) | 20) & 0xFu; }
#define XB_SPIN(cond, bar) do { unsigned _sp = 0; while (cond) { \
    if ((++_sp & 255u) == 0u) { if (xb_ld(&(bar)[XB_TMO])) break; if (_sp > XB_SPIN_CAP) { atomicAdd(&(bar)[XB_TMO], 1u); break; } } } } while (0)

struct XcdBarrier {
    volatile LAS unsigned* st;
};

__device__ __forceinline__ XcdBarrier xcd_barrier_post(unsigned* bar, volatile LAS unsigned* st) {
    XcdBarrier b; b.st = st;
    if (threadIdx.x == 0) { st[2] = (unsigned)(unsigned long long)bar; st[3] = (unsigned)((unsigned long long)bar >> 32); (void)xb_add(&bar[XB_XCNT(xb_xcc_id())], 1u); }
    return b;
}
__device__ __forceinline__ void xcd_barrier_complete(unsigned* bar, unsigned x, unsigned& nloc, unsigned& nx) {
    const unsigned G = gridDim.x * gridDim.y * gridDim.z;
    unsigned sum, cnt, mine, sp = 0u;
    for (;;) {
        sum = 0u; cnt = 0u; mine = 0u;
#pragma unroll
        for (unsigned j = 0; j < 16; ++j) { const unsigned c = xb_ld(&bar[XB_XCNT(j)]); sum += c; cnt += (c > 0u) ? 1u : 0u; mine = (j == x) ? c : mine; }
        if (sum == G) break;
        __builtin_amdgcn_s_sleep(1);
        if ((++sp & 255u) == 0u) { if (xb_ld(&bar[XB_TMO])) break; if (sp > XB_SPIN_CAP) { atomicAdd(&bar[XB_TMO], 1u); break; } }
    }
    nloc = mine > 0u ? mine : 1u; nx = cnt > 0u ? cnt : 1u;
}

struct XbNoWork { __device__ __forceinline__ void operator()(int) const {} };
template <class WORK = XbNoWork> __device__ __forceinline__ void xcd_barrier(const XcdBarrier& b, WORK work = WORK()) {
    asm volatile("s_waitcnt vmcnt(0)" ::: "memory");
    __syncthreads();
    if (threadIdx.x == 0) {
        unsigned* bar = (unsigned*)(((unsigned long long)b.st[3] << 32) | (unsigned long long)b.st[2]);
        const unsigned bx = xb_xcc_id();
        __builtin_amdgcn_s_waitcnt(0);
        unsigned nloc = b.st[0], nx = b.st[1];
        if (nloc == 0u) { xcd_barrier_complete(bar, bx, nloc, nx); b.st[0] = nloc; b.st[1] = nx; }
        const unsigned old = xb_add(&bar[XB_XSUB(bx)], 1u);
        const unsigned gen = old / nloc;
        if (old + 1u == (gen + 1u) * nloc) {
            __builtin_amdgcn_fence(__ATOMIC_RELEASE, "agent");
            asm volatile("s_waitcnt vmcnt(0)" ::: "memory");
            const unsigned og = xb_add(&bar[XB_TOP], 1u);
            const unsigned tg = og / nx;
            if (og + 1u != (tg + 1u) * nx) XB_SPIN(xb_ld(&bar[XB_TOP]) < (tg + 1u) * nx, bar);
            __builtin_amdgcn_fence(__ATOMIC_ACQUIRE, "agent");
            asm volatile("s_waitcnt vmcnt(0)" ::: "memory");
        } else {
            XB_SPIN(xb_ld(&bar[XB_TOP]) < (gen + 1u) * nx, bar);
            __builtin_amdgcn_fence(__ATOMIC_ACQUIRE, "agent");
            asm volatile("s_waitcnt vmcnt(0)" ::: "memory");
        }
    } else { int tw_ = threadIdx.x; asm volatile("" : "+v"(tw_)); if (tw_ >= 64) work(tw_ - 64); }
    __syncthreads();
}
constexpr int T_ = 8192, D_ = 2048, GW_ = 64, NROWS_ = 128, NZ_ = 5120;
constexpr float ALPHA_ = 1.681792830507429f;
constexpr float LN_EPS_ = 1e-5f;
constexpr int NTHR = 512;
constexpr int LDS_BYTES = 163840;
constexpr int LDS_BAR_OFF = LDS_BYTES - 16;
typedef unsigned short bf16_t;

__device__ __forceinline__ bf16_t f2bf(float f) { unsigned u = __float_as_uint(f); u += 0x7FFFu + ((u >> 16) & 1u); return (bf16_t)(u >> 16); }
__device__ __forceinline__ float bf2f(bf16_t b) { return __uint_as_float(((unsigned)b) << 16); }
__device__ __forceinline__ float gelu_exact(float v) { return 0.5f * v * (1.0f + erff(v * 0.70710678118654752f)); }
__device__ __forceinline__ float sigmoidf_(float v) { return 1.0f / (1.0f + expf(-v)); }
__device__ __forceinline__ int otid() { int t = threadIdx.x; asm volatile("" : "+v"(t)); return t; }
template <int CTRL> __device__ __forceinline__ float dpp_f(float v) { return __int_as_float(__builtin_amdgcn_update_dpp(0, __float_as_int(v), CTRL, 0xf, 0xf, true)); }
__device__ __forceinline__ float rows4_sum(float v) {
    const auto a = __builtin_amdgcn_permlane16_swap(__float_as_uint(v), __float_as_uint(v), false, false); v = __uint_as_float(a[0]) + __uint_as_float(a[1]);
    const auto b = __builtin_amdgcn_permlane32_swap(__float_as_uint(v), __float_as_uint(v), false, false); return __uint_as_float(b[0]) + __uint_as_float(b[1]); }
__device__ __forceinline__ float rows4_max(float v) {
    const auto a = __builtin_amdgcn_permlane16_swap(__float_as_uint(v), __float_as_uint(v), false, false); v = fmaxf(__uint_as_float(a[0]), __uint_as_float(a[1]));
    const auto b = __builtin_amdgcn_permlane32_swap(__float_as_uint(v), __float_as_uint(v), false, false); return fmaxf(__uint_as_float(b[0]), __uint_as_float(b[1])); }
__device__ __forceinline__ float wave_sum_f(float v) { v += dpp_f<0xB1>(v); v += dpp_f<0x4E>(v); v += dpp_f<0x141>(v); v += dpp_f<0x140>(v); return rows4_sum(v); }
__device__ __forceinline__ float wave_max_f(float v) { v = fmaxf(v, dpp_f<0xB1>(v)); v = fmaxf(v, dpp_f<0x4E>(v)); v = fmaxf(v, dpp_f<0x141>(v)); v = fmaxf(v, dpp_f<0x140>(v)); return rows4_max(v); }

struct Params {
    const float *x, *ev_w_in, *ev_conv_a, *ev_conv_b_w, *ev_conv_b_b, *ev_w_r, *ev_b_r, *ev_w_i, *ev_b_i, *ev_lam, *ev_w_out,
                *od_w_qkv, *od_rel_bias, *od_w_o, *pk_w_q, *pk_sub_keys, *pk_u, *pk_v, *ln1_g, *ln1_b, *ln2_g, *ln2_b;
    float* out;
    unsigned* bar;
    bf16_t *xb, *x1b, *Yb, *WinT, *WoutT, *WqkvT, *WoT, *WqT, *Wt;
    unsigned *Uq, *Vq, *x1q, *Wq8, *Win8, *Wqkv8, *xq;
    float *SU, *SV, *SX, *SUE, *WSC, *SW, *SWin, *SWqkv, *SXB;
    unsigned char* WQ;
    float *x1f, *x2f, *pre, *Z, *XC, *AA, *UU, *Gb;
    int* Eb;
};

__device__ __forceinline__ void phase_cvt_x(const Params& p) {
    const int tix = otid();
    const int lane = tix & 63, w = tix >> 6;
    const int rstep = (int)gridDim.x * 8;
    for (int r0 = (int)blockIdx.x * 8 + w; r0 < T_; r0 += 2 * rstep) {
        float4 v[2][8];
#pragma unroll
        for (int k = 0; k < 2; ++k) { const int t = (r0 + k * rstep < T_) ? r0 + k * rstep : r0;
#pragma unroll
            for (int i = 0; i < 8; ++i) v[k][i] = *(const float4*)(p.x + (size_t)t * D_ + i * 256 + lane * 4); }
#pragma unroll
        for (int k = 0; k < 2; ++k) { const int t = r0 + k * rstep;
            if (t < T_) { float m = 0.f;
#pragma unroll
                for (int i = 0; i < 8; ++i) { const float4 y = v[k][i]; m = fmaxf(m, fmaxf(fmaxf(fabsf(y.x), fabsf(y.y)), fmaxf(fabsf(y.z), fabsf(y.w))));
                    uint2 o; o.x = (unsigned)f2bf(y.x) | ((unsigned)f2bf(y.y) << 16); o.y = (unsigned)f2bf(y.z) | ((unsigned)f2bf(y.w) << 16);
                    *(uint2*)(p.xb + (size_t)t * D_ + i * 256 + lane * 4) = o; }
#pragma unroll
                for (int o = 32; o >= 1; o >>= 1) m = fmaxf(m, __shfl_xor(m, o));
                const float sc = m > 0.f ? 127.0f / m : 0.f;
#pragma unroll
                for (int i = 0; i < 8; ++i) { const int a = (int)rintf(v[k][i].x * sc), b = (int)rintf(v[k][i].y * sc), c = (int)rintf(v[k][i].z * sc), d = (int)rintf(v[k][i].w * sc);
                    p.xq[(size_t)t * 512 + i * 64 + lane] = (unsigned)(a & 255) | ((unsigned)(b & 255) << 8) | ((unsigned)(c & 255) << 16) | ((unsigned)(d & 255) << 24); }
                if (lane == 0) p.SXB[t] = m * (1.0f / 127.0f); } }
    }
}
__device__ __forceinline__ void phase_cvt_w(const Params& p, unsigned char* lds, int bid, int nb_, int ubeg, int uend) {
    const int tix = otid();
    float (*tile)[65] = (float (*)[65])lds;
    constexpr int NB_OUT = 2 * 2048 / 64, NB_O = 2 * 2048 / 64;
    constexpr int NB = NB_OUT + NB_O;
    const int tx = tix & 63, ty = tix >> 6;
    if (uend > NB * 8) uend = NB * 8;
    for (int u = ubeg + bid; u < uend; u += nb_) {
        int nb = u >> 3; const int kb = u & 7;
        const float* src; bf16_t* dst; int N, per;
        if (nb < NB_OUT) { src = p.ev_w_out; dst = p.WoutT; N = 2048; per = 32; }
        else { nb -= NB_OUT; src = p.od_w_o; dst = p.WoT; N = 2048; per = 32; }
        const int mat = nb / per, nbl = nb % per;
        src += (size_t)mat * 2048 * N; dst += (size_t)mat * 2048 * N;
        const int n0 = nbl * 64, k0 = kb * 256;
        int ns = n0;
        if (N == 5120 && n0 >= 3072) ns = (n0 < 4096) ? n0 + 1024 : n0 - 1024;
        float v[32];
#pragma unroll
        for (int i = 0; i < 32; ++i) v[i] = src[(size_t)(k0 + i * 8 + ty) * N + ns + tx];
        __syncthreads();
#pragma unroll
        for (int i = 0; i < 32; ++i) tile[i * 8 + ty][tx] = v[i];
        __syncthreads();
#pragma unroll
        for (int i = 0; i < 8; ++i) { const int n = i * 8 + ty;
#pragma unroll
            for (int j = 0; j < 2; ++j) { const int k = j * 128 + 2 * tx;
                *(unsigned*)(dst + (size_t)(n0 + n) * 2048 + k0 + k) = (unsigned)f2bf(tile[k][n]) | ((unsigned)f2bf(tile[k + 1][n]) << 16); } }
    }
}

__device__ __forceinline__ void phase_cvt_w8(const Params& p, unsigned char* lds) {
    const int tix = otid();
    const int lane = tix & 63, w = tix >> 6, tx = tix & 31, ty = tix >> 5;
    constexpr int NU_IN = 2 * 5120 / 32, NU_QKV = 2 * 6144 / 32, NU_Q = 4 * 2048 / 32, ROWB = 4112;
    for (int u = blockIdx.x; u < NU_IN + NU_QKV + NU_Q; u += gridDim.x) {
        int nb = u; const float* src; unsigned* dst8; float* sdst; int N, per;
        if (nb < NU_IN) { src = p.ev_w_in; dst8 = p.Win8; sdst = p.SWin; N = 5120; per = 160; }
        else if ((nb -= NU_IN) < NU_QKV) { src = p.od_w_qkv; dst8 = p.Wqkv8; sdst = p.SWqkv; N = 6144; per = 192; }
        else { nb -= NU_QKV; src = p.pk_w_q; dst8 = p.Wq8; sdst = p.SW; N = 2048; per = 64; }
        const int mat = nb / per, n0 = (nb % per) * 32;
        src += (size_t)mat * 2048 * N;
        int ns = n0;
        if (N == 5120 && n0 >= 3072) ns = (n0 < 4096) ? n0 + 1024 : n0 - 1024;
        const size_t orow0 = (size_t)mat * N + n0;
        __syncthreads();
#pragma unroll 1
        for (int b = 0; b < 2; ++b) { float v0[32], v1[32];
#pragma unroll
            for (int i = 0; i < 32; ++i) { const int k = b * 1024 + i * 32 + ty * 2; v0[i] = src[(size_t)k * N + ns + tx]; v1[i] = src[(size_t)(k + 1) * N + ns + tx]; }
#pragma unroll
            for (int i = 0; i < 32; ++i) { const int k = b * 1024 + i * 32 + ty * 2; *(unsigned*)(lds + tx * ROWB + k * 2) = (unsigned)f2bf(v0[i]) | ((unsigned)f2bf(v1[i]) << 16); } }
        __syncthreads();
#pragma unroll 1
        for (int r = 0; r < 4; ++r) { const int n = w * 4 + r;
            const uint4* rowp = (const uint4*)(lds + n * ROWB) + lane * 4;
            float f[32]; float m = 0.f;
#pragma unroll
            for (int j = 0; j < 4; ++j) { const uint4 q = rowp[j];
                f[j * 8 + 0] = __uint_as_float(q.x << 16); f[j * 8 + 1] = __uint_as_float(q.x & 0xffff0000u); f[j * 8 + 2] = __uint_as_float(q.y << 16); f[j * 8 + 3] = __uint_as_float(q.y & 0xffff0000u);
                f[j * 8 + 4] = __uint_as_float(q.z << 16); f[j * 8 + 5] = __uint_as_float(q.z & 0xffff0000u); f[j * 8 + 6] = __uint_as_float(q.w << 16); f[j * 8 + 7] = __uint_as_float(q.w & 0xffff0000u); }
#pragma unroll
            for (int j = 0; j < 32; ++j) m = fmaxf(m, fabsf(f[j]));
            m = wave_max_f(m);
            const float sc = m > 0.f ? 127.0f / m : 0.f;
            unsigned o[8];
#pragma unroll
            for (int j = 0; j < 8; ++j) { const int a = (int)rintf(f[4 * j] * sc), b2 = (int)rintf(f[4 * j + 1] * sc), c = (int)rintf(f[4 * j + 2] * sc), d = (int)rintf(f[4 * j + 3] * sc);
                o[j] = (unsigned)(a & 255) | ((unsigned)(b2 & 255) << 8) | ((unsigned)(c & 255) << 16) | ((unsigned)(d & 255) << 24); }
            uint4* op = (uint4*)(dst8 + (orow0 + n) * 512 + lane * 8);
            op[0] = make_uint4(o[0], o[1], o[2], o[3]); op[1] = make_uint4(o[4], o[5], o[6], o[7]);
            if (lane == 0) sdst[orow0 + n] = m * (1.0f / 127.0f);
        }
    }
}

#define TK_CE(x, y) do { const float hi_ = fmaxf(x, y), lo_ = fminf(x, y); x = hi_; y = lo_; } while (0)
#define TK_SORT2X16(a) do { TK_CE(a[0], a[1]); TK_CE(a[3], a[2]); TK_CE(a[4], a[5]); TK_CE(a[7], a[6]); TK_CE(a[8], a[9]); TK_CE(a[11], a[10]); TK_CE(a[12], a[13]); TK_CE(a[15], a[14]); TK_CE(a[0], a[2]); TK_CE(a[1], a[3]); TK_CE(a[6], a[4]); TK_CE(a[7], a[5]); TK_CE(a[8], a[10]); TK_CE(a[9], a[11]); TK_CE(a[14], a[12]); TK_CE(a[15], a[13]); TK_CE(a[0], a[1]); TK_CE(a[2], a[3]); TK_CE(a[5], a[4]); TK_CE(a[7], a[6]); TK_CE(a[8], a[9]); TK_CE(a[10], a[11]); TK_CE(a[13], a[12]); TK_CE(a[15], a[14]); TK_CE(a[0], a[4]); TK_CE(a[1], a[5]); TK_CE(a[2], a[6]); TK_CE(a[3], a[7]); TK_CE(a[12], a[8]); TK_CE(a[13], a[9]); TK_CE(a[14], a[10]); TK_CE(a[15], a[11]); TK_CE(a[0], a[2]); TK_CE(a[1], a[3]); TK_CE(a[4], a[6]); TK_CE(a[5], a[7]); TK_CE(a[10], a[8]); TK_CE(a[11], a[9]); TK_CE(a[14], a[12]); TK_CE(a[15], a[13]); TK_CE(a[0], a[1]); TK_CE(a[2], a[3]); TK_CE(a[4], a[5]); TK_CE(a[6], a[7]); TK_CE(a[9], a[8]); TK_CE(a[11], a[10]); TK_CE(a[13], a[12]); TK_CE(a[15], a[14]); TK_CE(a[0], a[8]); TK_CE(a[1], a[9]); TK_CE(a[2], a[10]); TK_CE(a[3], a[11]); TK_CE(a[4], a[12]); TK_CE(a[5], a[13]); TK_CE(a[6], a[14]); TK_CE(a[7], a[15]); TK_CE(a[0], a[4]); TK_CE(a[1], a[5]); TK_CE(a[2], a[6]); TK_CE(a[3], a[7]); TK_CE(a[8], a[12]); TK_CE(a[9], a[13]); TK_CE(a[10], a[14]); TK_CE(a[11], a[15]); TK_CE(a[0], a[2]); TK_CE(a[1], a[3]); TK_CE(a[4], a[6]); TK_CE(a[5], a[7]); TK_CE(a[8], a[10]); TK_CE(a[9], a[11]); TK_CE(a[12], a[14]); TK_CE(a[13], a[15]); TK_CE(a[0], a[1]); TK_CE(a[2], a[3]); TK_CE(a[4], a[5]); TK_CE(a[6], a[7]); TK_CE(a[8], a[9]); TK_CE(a[10], a[11]); TK_CE(a[12], a[13]); TK_CE(a[14], a[15]); TK_CE(a[16], a[17]); TK_CE(a[19], a[18]); TK_CE(a[20], a[21]); TK_CE(a[23], a[22]); TK_CE(a[24], a[25]); TK_CE(a[27], a[26]); TK_CE(a[28], a[29]); TK_CE(a[31], a[30]); TK_CE(a[16], a[18]); TK_CE(a[17], a[19]); TK_CE(a[22], a[20]); TK_CE(a[23], a[21]); TK_CE(a[24], a[26]); TK_CE(a[25], a[27]); TK_CE(a[30], a[28]); TK_CE(a[31], a[29]); TK_CE(a[16], a[17]); TK_CE(a[18], a[19]); TK_CE(a[21], a[20]); TK_CE(a[23], a[22]); TK_CE(a[24], a[25]); TK_CE(a[26], a[27]); TK_CE(a[29], a[28]); TK_CE(a[31], a[30]); TK_CE(a[16], a[20]); TK_CE(a[17], a[21]); TK_CE(a[18], a[22]); TK_CE(a[19], a[23]); TK_CE(a[28], a[24]); TK_CE(a[29], a[25]); TK_CE(a[30], a[26]); TK_CE(a[31], a[27]); TK_CE(a[16], a[18]); TK_CE(a[17], a[19]); TK_CE(a[20], a[22]); TK_CE(a[21], a[23]); TK_CE(a[26], a[24]); TK_CE(a[27], a[25]); TK_CE(a[30], a[28]); TK_CE(a[31], a[29]); TK_CE(a[16], a[17]); TK_CE(a[18], a[19]); TK_CE(a[20], a[21]); TK_CE(a[22], a[23]); TK_CE(a[25], a[24]); TK_CE(a[27], a[26]); TK_CE(a[29], a[28]); TK_CE(a[31], a[30]); TK_CE(a[16], a[24]); TK_CE(a[17], a[25]); TK_CE(a[18], a[26]); TK_CE(a[19], a[27]); TK_CE(a[20], a[28]); TK_CE(a[21], a[29]); TK_CE(a[22], a[30]); TK_CE(a[23], a[31]); TK_CE(a[16], a[20]); TK_CE(a[17], a[21]); TK_CE(a[18], a[22]); TK_CE(a[19], a[23]); TK_CE(a[24], a[28]); TK_CE(a[25], a[29]); TK_CE(a[26], a[30]); TK_CE(a[27], a[31]); TK_CE(a[16], a[18]); TK_CE(a[17], a[19]); TK_CE(a[20], a[22]); TK_CE(a[21], a[23]); TK_CE(a[24], a[26]); TK_CE(a[25], a[27]); TK_CE(a[28], a[30]); TK_CE(a[29], a[31]); TK_CE(a[16], a[17]); TK_CE(a[18], a[19]); TK_CE(a[20], a[21]); TK_CE(a[22], a[23]); TK_CE(a[24], a[25]); TK_CE(a[26], a[27]); TK_CE(a[28], a[29]); TK_CE(a[30], a[31]); } while (0)
#define TK_MERGE16(c) do { TK_CE(c[0], c[8]); TK_CE(c[1], c[9]); TK_CE(c[2], c[10]); TK_CE(c[3], c[11]); TK_CE(c[4], c[12]); TK_CE(c[5], c[13]); TK_CE(c[6], c[14]); TK_CE(c[7], c[15]); TK_CE(c[0], c[4]); TK_CE(c[1], c[5]); TK_CE(c[2], c[6]); TK_CE(c[3], c[7]); TK_CE(c[8], c[12]); TK_CE(c[9], c[13]); TK_CE(c[10], c[14]); TK_CE(c[11], c[15]); TK_CE(c[0], c[2]); TK_CE(c[1], c[3]); TK_CE(c[4], c[6]); TK_CE(c[5], c[7]); TK_CE(c[8], c[10]); TK_CE(c[9], c[11]); TK_CE(c[12], c[14]); TK_CE(c[13], c[15]); TK_CE(c[0], c[1]); TK_CE(c[2], c[3]); TK_CE(c[4], c[5]); TK_CE(c[6], c[7]); TK_CE(c[8], c[9]); TK_CE(c[10], c[11]); TK_CE(c[12], c[13]); TK_CE(c[14], c[15]); } while (0)
#define TK_SORT16(a) do { TK_CE(a[0], a[13]); TK_CE(a[1], a[12]); TK_CE(a[2], a[15]); TK_CE(a[3], a[14]); TK_CE(a[4], a[8]); TK_CE(a[5], a[6]); TK_CE(a[7], a[11]); TK_CE(a[9], a[10]); TK_CE(a[0], a[5]); TK_CE(a[1], a[7]); TK_CE(a[2], a[9]); TK_CE(a[3], a[4]); TK_CE(a[6], a[13]); TK_CE(a[8], a[14]); TK_CE(a[10], a[15]); TK_CE(a[11], a[12]); TK_CE(a[0], a[1]); TK_CE(a[2], a[3]); TK_CE(a[4], a[5]); TK_CE(a[6], a[8]); TK_CE(a[7], a[9]); TK_CE(a[10], a[11]); TK_CE(a[12], a[13]); TK_CE(a[14], a[15]); TK_CE(a[0], a[2]); TK_CE(a[1], a[3]); TK_CE(a[4], a[10]); TK_CE(a[5], a[11]); TK_CE(a[6], a[7]); TK_CE(a[8], a[9]); TK_CE(a[12], a[14]); TK_CE(a[13], a[15]); TK_CE(a[1], a[2]); TK_CE(a[3], a[12]); TK_CE(a[4], a[6]); TK_CE(a[5], a[7]); TK_CE(a[8], a[10]); TK_CE(a[9], a[11]); TK_CE(a[13], a[14]); TK_CE(a[1], a[4]); TK_CE(a[2], a[6]); TK_CE(a[5], a[8]); TK_CE(a[7], a[10]); TK_CE(a[9], a[13]); TK_CE(a[11], a[14]); TK_CE(a[2], a[4]); TK_CE(a[3], a[6]); TK_CE(a[9], a[12]); TK_CE(a[11], a[13]); TK_CE(a[3], a[5]); TK_CE(a[6], a[8]); TK_CE(a[7], a[9]); TK_CE(a[10], a[12]); TK_CE(a[3], a[4]); TK_CE(a[5], a[6]); TK_CE(a[7], a[8]); TK_CE(a[9], a[10]); TK_CE(a[11], a[12]); TK_CE(a[6], a[7]); TK_CE(a[8], a[9]); } while (0)
#define TK_SORT16H(a) do { TK_CE(a[16 + 0], a[16 + 13]); TK_CE(a[16 + 1], a[16 + 12]); TK_CE(a[16 + 2], a[16 + 15]); TK_CE(a[16 + 3], a[16 + 14]); TK_CE(a[16 + 4], a[16 + 8]); TK_CE(a[16 + 5], a[16 + 6]); TK_CE(a[16 + 7], a[16 + 11]); TK_CE(a[16 + 9], a[16 + 10]); TK_CE(a[16 + 0], a[16 + 5]); TK_CE(a[16 + 1], a[16 + 7]); TK_CE(a[16 + 2], a[16 + 9]); TK_CE(a[16 + 3], a[16 + 4]); TK_CE(a[16 + 6], a[16 + 13]); TK_CE(a[16 + 8], a[16 + 14]); TK_CE(a[16 + 10], a[16 + 15]); TK_CE(a[16 + 11], a[16 + 12]); TK_CE(a[16 + 0], a[16 + 1]); TK_CE(a[16 + 2], a[16 + 3]); TK_CE(a[16 + 4], a[16 + 5]); TK_CE(a[16 + 6], a[16 + 8]); TK_CE(a[16 + 7], a[16 + 9]); TK_CE(a[16 + 10], a[16 + 11]); TK_CE(a[16 + 12], a[16 + 13]); TK_CE(a[16 + 14], a[16 + 15]); TK_CE(a[16 + 0], a[16 + 2]); TK_CE(a[16 + 1], a[16 + 3]); TK_CE(a[16 + 4], a[16 + 10]); TK_CE(a[16 + 5], a[16 + 11]); TK_CE(a[16 + 6], a[16 + 7]); TK_CE(a[16 + 8], a[16 + 9]); TK_CE(a[16 + 12], a[16 + 14]); TK_CE(a[16 + 13], a[16 + 15]); TK_CE(a[16 + 1], a[16 + 2]); TK_CE(a[16 + 3], a[16 + 12]); TK_CE(a[16 + 4], a[16 + 6]); TK_CE(a[16 + 5], a[16 + 7]); TK_CE(a[16 + 8], a[16 + 10]); TK_CE(a[16 + 9], a[16 + 11]); TK_CE(a[16 + 13], a[16 + 14]); TK_CE(a[16 + 1], a[16 + 4]); TK_CE(a[16 + 2], a[16 + 6]); TK_CE(a[16 + 5], a[16 + 8]); TK_CE(a[16 + 7], a[16 + 10]); TK_CE(a[16 + 9], a[16 + 13]); TK_CE(a[16 + 11], a[16 + 14]); TK_CE(a[16 + 2], a[16 + 4]); TK_CE(a[16 + 3], a[16 + 6]); TK_CE(a[16 + 9], a[16 + 12]); TK_CE(a[16 + 11], a[16 + 13]); TK_CE(a[16 + 3], a[16 + 5]); TK_CE(a[16 + 6], a[16 + 8]); TK_CE(a[16 + 7], a[16 + 9]); TK_CE(a[16 + 10], a[16 + 12]); TK_CE(a[16 + 3], a[16 + 4]); TK_CE(a[16 + 5], a[16 + 6]); TK_CE(a[16 + 7], a[16 + 8]); TK_CE(a[16 + 9], a[16 + 10]); TK_CE(a[16 + 11], a[16 + 12]); TK_CE(a[16 + 6], a[16 + 7]); TK_CE(a[16 + 8], a[16 + 9]); } while (0)
#define TK_SORT13(a) do { TK_CE(a[1], a[12]); TK_CE(a[4], a[8]); TK_CE(a[5], a[6]); TK_CE(a[7], a[11]); TK_CE(a[9], a[10]); TK_CE(a[0], a[5]); TK_CE(a[1], a[7]); TK_CE(a[2], a[9]); TK_CE(a[3], a[4]); TK_CE(a[11], a[12]); TK_CE(a[0], a[1]); TK_CE(a[2], a[3]); TK_CE(a[4], a[5]); TK_CE(a[6], a[8]); TK_CE(a[7], a[9]); TK_CE(a[10], a[11]); TK_CE(a[0], a[2]); TK_CE(a[1], a[3]); TK_CE(a[4], a[10]); TK_CE(a[5], a[11]); TK_CE(a[6], a[7]); TK_CE(a[8], a[9]); TK_CE(a[1], a[2]); TK_CE(a[3], a[12]); TK_CE(a[4], a[6]); TK_CE(a[5], a[7]); TK_CE(a[8], a[10]); TK_CE(a[9], a[11]); TK_CE(a[1], a[4]); TK_CE(a[2], a[6]); TK_CE(a[5], a[8]); TK_CE(a[7], a[10]); TK_CE(a[2], a[4]); TK_CE(a[3], a[6]); TK_CE(a[9], a[12]); TK_CE(a[3], a[5]); TK_CE(a[6], a[8]); TK_CE(a[7], a[9]); TK_CE(a[10], a[12]); TK_CE(a[3], a[4]); TK_CE(a[5], a[6]); TK_CE(a[7], a[8]); TK_CE(a[9], a[10]); TK_CE(a[11], a[12]); TK_CE(a[6], a[7]); TK_CE(a[8], a[9]); } while (0)
#undef TK_CE
__device__ __forceinline__ void tk_ce(float& x, float& y) { float hi, lo; asm("v_max_f32 %0, %2, %3\n\tv_min_f32 %1, %2, %3" : "=&v"(hi), "=v"(lo) : "v"(x), "v"(y)); x = hi; y = lo; }
#define TK_CE(x, y) tk_ce(x, y)
__device__ __forceinline__ float tk_max(float x, float y) { float r; asm("v_max_f32 %0, %1, %2" : "=v"(r) : "v"(x), "v"(y)); return r; }
__device__ __forceinline__ float tk_sel(float a, float b, unsigned long long m) { float r; asm("v_cndmask_b32 %0, %1, %2, %3" : "=v"(r) : "v"(a), "v"(b), "s"(m)); return r; }
__device__ __forceinline__ float tk_sel4(float a0, float a1, float a2, float a3) {
    return tk_sel(tk_sel(a0, a1, 0xFFFF0000FFFF0000ull), tk_sel(a2, a3, 0xFFFF0000FFFF0000ull), 0xFFFFFFFF00000000ull); }
typedef __attribute__((ext_vector_type(2))) __bf16 bf16x2_t;
__device__ __forceinline__ float dot2bf(unsigned a, unsigned b, float acc) { return __builtin_amdgcn_fdot2_f32_bf16(__builtin_bit_cast(bf16x2_t, a), __builtin_bit_cast(bf16x2_t, b), acc, false); }
template <class VA, class VB> __device__ __forceinline__ float dot8bf(const VA a, const VB b, float acc) { acc = dot2bf(a.x, b.x, acc); acc = dot2bf(a.y, b.y, acc); acc = dot2bf(a.z, b.z, acc); return dot2bf(a.w, b.w, acc); }
__device__ __forceinline__ float wave_sum(float v) { return wave_sum_f(v); }
__device__ __forceinline__ unsigned pack2bf(float lo, float hi) { return (unsigned)f2bf(lo) | ((unsigned)f2bf(hi) << 16); }

__device__ __forceinline__ void cvt_stream(const float* __restrict__ src, bf16_t* __restrict__ dst, size_t n4, int tix) {
    for (size_t i = (size_t)blockIdx.x * NTHR + tix; i < n4; i += (size_t)gridDim.x * NTHR) {
        const float4 v = ((const float4*)src)[i]; uint2 o; o.x = pack2bf(v.x, v.y); o.y = pack2bf(v.z, v.w); ((uint2*)dst)[i] = o; }
}

#define SK_ROWB 272
#define TK2_TAB 71680
__device__ __forceinline__ float sel4f(int g, float a0, float a1, float a2, float a3) { return g == 0 ? a0 : (g == 1 ? a1 : (g == 2 ? a2 : a3)); }
struct TopkStage { const float* sk; unsigned char* lds;
    __device__ __forceinline__ void operator()(int i0) const {
        for (int idx = i0; idx < 2 * 128 * 32; idx += NTHR - 64) { const float4 v = ((const float4*)sk)[idx]; const int row = idx >> 5, c4 = idx & 31;
            uint2 o; o.x = pack2bf(v.x, v.y); o.y = pack2bf(v.z, v.w); *(uint2*)(lds + row * SK_ROWB + c4 * 8) = o; } } };
__device__ __forceinline__ void phase_topk(const bf16_t* __restrict__ Qb, const float* __restrict__ sk, unsigned short* __restrict__ E, float* __restrict__ G, unsigned char* lds,
                                           const float* __restrict__ SU = nullptr, const float* __restrict__ SV = nullptr, float* __restrict__ SUE = nullptr) {
    const int tix = otid();
    const int lane = tix & 63, w = tix >> 6, tok = lane & 15, g = lane >> 4;
    constexpr int PI[4][13] = {{0,0,0,0,0,0,0,0,0,0,0,0,0}, {0,0,0,1,1,1,1,1,1,1,1,2,2}, {2,2,2,3,3,3,3,4,4,4,5,5,6}, {6,7,7,8,9,10,11,12,13,14,15,0,0}};
    constexpr int PJ[4][13] = {{0,1,2,3,4,5,6,7,8,9,10,11,12}, {13,14,15,0,1,2,3,4,5,6,7,0,1}, {2,3,4,0,1,2,3,0,1,2,0,1,0}, {1,0,1,0,0,0,0,0,0,0,0,0,0}};
    const float NINF = -INFINITY;
    for (int tile = blockIdx.x; tile < T_ / 16; tile += gridDim.x) {
        const int t0 = tile * 16;
        const bf16_t* qrow = Qb + (size_t)(t0 + tok) * 2048 + w * 256 + g * 8;
        pg8::bf16x8 bq[2][4];
#pragma unroll
        for (int pp = 0; pp < 2; ++pp)
#pragma unroll
            for (int ks = 0; ks < 4; ++ks) bq[pp][ks] = *(const pg8::bf16x8*)(qrow + pp * 128 + ks * 32);
        float top[2][16];
#pragma unroll
        for (int pp = 0; pp < 2; ++pp) {
            pg8::f32x4 acc[8];
#pragma unroll
            for (int kt = 0; kt < 8; ++kt) { acc[kt] = (pg8::f32x4){0.f, 0.f, 0.f, 0.f};
#pragma unroll
                for (int ks = 0; ks < 4; ++ks) { const pg8::bf16x8 a = *(const pg8::bf16x8*)(lds + (pp * 128 + kt * 16 + tok) * SK_ROWB + (ks * 32 + g * 8) * 2);
                    acc[kt] = __builtin_amdgcn_mfma_f32_16x16x32_bf16(a, bq[pp][ks], acc[kt], 0, 0, 0); }
                if (kt & 1) __builtin_amdgcn_sched_barrier(0); }
            float sc[32];
#pragma unroll
            for (int kt = 0; kt < 8; ++kt)
#pragma unroll
                for (int r = 0; r < 4; ++r) sc[kt * 4 + r] = __uint_as_float((__float_as_uint(acc[kt][r]) & ~127u) | (unsigned)(kt * 16 + g * 4 + r));
            TK_SORT16(sc); TK_SORT16H(sc);
            float c[16];
#pragma unroll
            for (int i = 0; i < 16; ++i) c[i] = tk_max(sc[i], sc[31 - i]);
            TK_MERGE16(c);
#pragma unroll
            for (int st = 16; st <= 32; st <<= 1) { float pr[16];
#pragma unroll
                for (int i = 0; i < 16; ++i) pr[i] = __shfl_xor(c[15 - i], st);
#pragma unroll
                for (int i = 0; i < 16; ++i) c[i] = tk_max(c[i], pr[i]);
                TK_MERGE16(c); }
#pragma unroll
            for (int i = 0; i < 16; ++i) top[pp][i] = c[i];
        }
        float cs[16];
        unsigned* ctab = (unsigned*)(lds + TK2_TAB + w * 2048) + lane;
        unsigned cprev = 0;
#pragma unroll
        for (int k = 0; k < 13; ++k) {
            const float a = tk_sel4(top[0][PI[0][k]], top[0][PI[1][k]], top[0][PI[2][k]], top[0][PI[3][k]]);
            const float b = tk_sel4(top[1][PJ[0][k]], top[1][PJ[1][k]], top[1][PJ[2][k]], top[1][PJ[3][k]]);
            const unsigned ua = __float_as_uint(a), ub = __float_as_uint(b);
            const float sum = __uint_as_float(ua & ~127u) + __uint_as_float(ub & ~127u);
            float c = __uint_as_float((__float_as_uint(sum) & ~63u) | (unsigned)(g * 16 + k));
            if (k >= 11) c = (g == 3) ? NINF : c;
            cs[k] = c;
            const unsigned ce = ((ua & 127u) << 7) | (ub & 127u);
            if (k & 1) ctab[(k >> 1) * 64] = cprev | (ce << 16); else cprev = ce;
        }
        ctab[6 * 64] = cprev;
        cs[13] = NINF; cs[14] = NINF; cs[15] = NINF;
        TK_SORT13(cs);
#pragma unroll
        for (int st = 16; st <= 32; st <<= 1) { float pr[16];
#pragma unroll
            for (int i = 0; i < 16; ++i) pr[i] = __shfl_xor(cs[15 - i], st);
#pragma unroll
            for (int i = 0; i < 16; ++i) cs[i] = tk_max(cs[i], pr[i]);
            TK_MERGE16(cs); }
        const float cv0 = __uint_as_float(__float_as_uint(cs[0]) & ~63u);
        const unsigned char* cbase = lds + TK2_TAB + w * 2048 + tok * 4;
        int eo4[4]; float ex4[4]; float sum = 0.f;
#pragma unroll
        for (int j = 0; j < 4; ++j) {
            const unsigned wb = __float_as_uint(tk_sel4(cs[j], cs[4 + j], cs[8 + j], cs[12 + j]));
            const unsigned id = wb & 63u;
            eo4[j] = (int)((*(const unsigned*)(cbase + ((id & 14u) << 7) + ((id & 48u) << 2)) >> ((id & 1u) << 4)) & 0xFFFFu);
            ex4[j] = expf(__uint_as_float(wb & ~63u) - cv0); sum += ex4[j];
        }
        sum = rows4_sum(sum);
        const float inv = 1.0f / sum;
        int4 eout; float4 gout;
        eout.x = eo4[0]; eout.y = eo4[1]; eout.z = eo4[2]; eout.w = eo4[3];
        gout.x = ex4[0] * inv; gout.y = ex4[1] * inv; gout.z = ex4[2] * inv; gout.w = ex4[3] * inv;
        const size_t o = (size_t)(t0 + tok) * 128 + w * 16 + g * 4;
        if (SUE) { gout.x *= SV[eout.x]; gout.y *= SV[eout.y]; gout.z *= SV[eout.z]; gout.w *= SV[eout.w];
            *(float4*)(SUE + o) = make_float4(SU[eout.x], SU[eout.y], SU[eout.z], SU[eout.w]); }
        *(uint2*)(E + o) = make_uint2((unsigned)eout.x | ((unsigned)eout.y << 16), (unsigned)eout.z | ((unsigned)eout.w << 16)); *(float4*)(G + o) = gout;
    }
}

typedef unsigned u4q_t __attribute__((ext_vector_type(4)));
typedef float f2q_t __attribute__((ext_vector_type(2)));
template <int CTRL> __device__ __forceinline__ int dpp_i(int v) { return __builtin_amdgcn_update_dpp(0, v, CTRL, 0xf, 0xf, true); }
__device__ __forceinline__ int row_sum_i(int v) { v += dpp_i<0xB1>(v); v += dpp_i<0x4E>(v); v += dpp_i<0x141>(v); v += dpp_i<0x140>(v); return v; }

template <bool ADD> __device__ __forceinline__ void phase_lnq(const bf16_t* __restrict__ inb, const bf16_t* __restrict__ addb, const float* __restrict__ gam, const float* __restrict__ bet,
                                                              float* __restrict__ outf, bf16_t* __restrict__ outb, unsigned* __restrict__ outq, float* __restrict__ outs) {
    constexpr int RB = 2;
    const int tix = otid();
    const int lane = tix & 63, w = tix >> 6;
    const int rstep = gridDim.x * 8;
    for (int r0 = blockIdx.x * 8 + w; r0 < T_; r0 += rstep * RB) {
        uint2 xb2[RB][8], yb2[RB][ADD ? 8 : 1];
#pragma unroll
        for (int k = 0; k < RB; ++k) { const int t = (r0 + k * rstep < T_) ? r0 + k * rstep : r0;
#pragma unroll
            for (int i = 0; i < 8; ++i) { const size_t o = (size_t)t * D_ + i * 256 + lane * 4;
                xb2[k][i] = *(const uint2*)(inb + o);
                if (ADD) yb2[k][i] = *(const uint2*)(addb + o); } }
#pragma unroll
        for (int k = 0; k < RB; ++k) { const int t = r0 + k * rstep;
            if (t < T_) {
                float4 v[8]; float s = 0.f;
#pragma unroll
                for (int i = 0; i < 8; ++i) {
                    v[i] = make_float4(__uint_as_float(xb2[k][i].x << 16), __uint_as_float(xb2[k][i].x & 0xffff0000u), __uint_as_float(xb2[k][i].y << 16), __uint_as_float(xb2[k][i].y & 0xffff0000u));
                    if (ADD) { const uint2 yb = yb2[k][ADD ? i : 0];
                        v[i].x = ALPHA_ * v[i].x + __uint_as_float(yb.x << 16); v[i].y = ALPHA_ * v[i].y + __uint_as_float(yb.x & 0xffff0000u);
                        v[i].z = ALPHA_ * v[i].z + __uint_as_float(yb.y << 16); v[i].w = ALPHA_ * v[i].w + __uint_as_float(yb.y & 0xffff0000u); }
                    s += v[i].x + v[i].y + v[i].z + v[i].w; }
                s = wave_sum(s);
                const float mu = s * (1.0f / D_);
                float q = 0.f;
#pragma unroll
                for (int i = 0; i < 8; ++i) { v[i].x -= mu; v[i].y -= mu; v[i].z -= mu; v[i].w -= mu; q += v[i].x * v[i].x + v[i].y * v[i].y + v[i].z * v[i].z + v[i].w * v[i].w; }
                q = wave_sum(q);
                const float rstd = rsqrtf(q * (1.0f / D_) + LN_EPS_);
                float m = 0.f;
#pragma unroll
                for (int i = 0; i < 8; ++i) { const int c = i * 256 + lane * 4; const float4 g = *(const float4*)(gam + c), b = *(const float4*)(bet + c);
                    float4 y; y.x = v[i].x * rstd * g.x + b.x; y.y = v[i].y * rstd * g.y + b.y; y.z = v[i].z * rstd * g.z + b.z; y.w = v[i].w * rstd * g.w + b.w;
                    v[i] = y; m = fmaxf(m, fmaxf(fmaxf(fabsf(y.x), fabsf(y.y)), fmaxf(fabsf(y.z), fabsf(y.w))));
                    if (outf) *(float4*)(outf + (size_t)t * D_ + c) = y;
                    if (outb) { uint2 o; o.x = pack2bf(y.x, y.y); o.y = pack2bf(y.z, y.w); *(uint2*)(outb + (size_t)t * D_ + c) = o; } }
                if (outq) {
                    m = wave_max_f(m);
                    const float sc = m > 0.f ? 119.0f / m : 0.f;
#pragma unroll
                    for (int i = 0; i < 8; ++i) { const int a = (int)rintf(v[i].x * sc), b = (int)rintf(v[i].y * sc), c = (int)rintf(v[i].z * sc), d = (int)rintf(v[i].w * sc);
                        outq[(size_t)t * 512 + i * 64 + lane] = (unsigned)(a & 255) | ((unsigned)(b & 255) << 8) | ((unsigned)(c & 255) << 16) | ((unsigned)(d & 255) << 24); }
                    if (lane == 0) outs[t] = m * (1.0f / 119.0f);
                }
            }
        }
    }
}

#define U8_COMP(RR, xx, zz) do { _Pragma("unroll") for (int j = 0; j < 16; ++j) { \
        int d = __builtin_amdgcn_sdot4((int)RR[j].x, (int)xx.x, 0, false); d = __builtin_amdgcn_sdot4((int)RR[j].y, (int)xx.y, d, false); \
        d = __builtin_amdgcn_sdot4((int)RR[j].z, (int)xx.z, d, false); d = __builtin_amdgcn_sdot4((int)RR[j].w, (int)xx.w, d, false); \
        d = row_sum_i(d); zz = (L == j) ? d : zz; } } while (0)
__device__ __forceinline__ unsigned permb(unsigned hi, unsigned lo, unsigned sel) { return __builtin_amdgcn_perm(hi, lo, sel); }
__device__ __forceinline__ void phase_quant_tables_i8(const float* __restrict__ pu, const float* __restrict__ pv, unsigned* __restrict__ Uq, unsigned* __restrict__ Vq,
                                                      float* __restrict__ SU, float* __restrict__ SV, int bid, int nb_, int vbeg, int vend) {
    const int tix = otid();
    const int lane = tix & 63, w = tix >> 6;
    for (int vr0 = vbeg + (bid * 8 + w) * 2; vr0 < vend; vr0 += nb_ * 16) {
        float4 v[2][8]; float m[2] = {0.f, 0.f};
#pragma unroll
        for (int k = 0; k < 2; ++k) { const int vr = (vr0 + k < vend) ? vr0 + k : vr0; const int tab = (vr >> 14) & 1, rr = ((vr >> 15) << 14) | (vr & 16383);
            const float* src = (tab ? pv : pu) + (size_t)rr * 2048;
#pragma unroll
            for (int i = 0; i < 8; ++i) v[k][i] = *(const float4*)(src + i * 256 + lane * 4); }
#pragma unroll
        for (int k = 0; k < 2; ++k) {
#pragma unroll
            for (int i = 0; i < 8; ++i) m[k] = fmaxf(m[k], fmaxf(fmaxf(fabsf(v[k][i].x), fabsf(v[k][i].y)), fmaxf(fabsf(v[k][i].z), fabsf(v[k][i].w))));
#pragma unroll
            for (int o = 32; o >= 1; o >>= 1) m[k] = fmaxf(m[k], __shfl_xor(m[k], o));
            const int vr = (vr0 + k < vend) ? vr0 + k : vr0; const int tab = (vr >> 14) & 1, rr = ((vr >> 15) << 14) | (vr & 16383);
            if (tab) {
                const float sc = m[k] > 0.f ? 127.0f / m[k] : 0.f;
                unsigned* dst = Vq + (size_t)rr * 512 + lane;
#pragma unroll
                for (int i = 0; i < 8; ++i) { const int a = (int)rintf(v[k][i].x * sc), b = (int)rintf(v[k][i].y * sc), c = (int)rintf(v[k][i].z * sc), d = (int)rintf(v[k][i].w * sc);
                    dst[i * 64] = (unsigned)(a & 255) | ((unsigned)(b & 255) << 8) | ((unsigned)(c & 255) << 16) | ((unsigned)(d & 255) << 24); }
                if (lane == 0) SV[rr] = m[k] * (1.0f / 127.0f);
            } else {
                const float sc = m[k] > 0.f ? 7.0f / m[k] : 0.f;
                unsigned* dst = Uq + (size_t)rr * 256 + (lane >> 1);
#pragma unroll
                for (int i = 0; i < 8; ++i) { const int a = (int)rintf(v[k][i].x * sc) & 15, b = (int)rintf(v[k][i].y * sc) & 15, c = (int)rintf(v[k][i].z * sc) & 15, d = (int)rintf(v[k][i].w * sc) & 15;
                    const unsigned mine = (unsigned)a | ((unsigned)b << 8) | ((unsigned)c << 16) | ((unsigned)d << 24);
                    const unsigned other = (unsigned)__builtin_amdgcn_update_dpp(0, (int)mine, 0xB1, 0xf, 0xf, true);
                    if (!(lane & 1)) dst[i * 32] = mine | (other << 4); }
                if (lane == 0) SU[rr] = m[k] * (1.0f / 7.0f);
            }
        }
    }
}

__device__ __forceinline__ void wq_bf8_to_f(const uint4 v, float (&f)[8]) {
    f[0] = __uint_as_float(v.x << 16); f[1] = __uint_as_float(v.x & 0xffff0000u); f[2] = __uint_as_float(v.y << 16); f[3] = __uint_as_float(v.y & 0xffff0000u);
    f[4] = __uint_as_float(v.z << 16); f[5] = __uint_as_float(v.z & 0xffff0000u); f[6] = __uint_as_float(v.w << 16); f[7] = __uint_as_float(v.w & 0xffff0000u); }
__device__ __forceinline__ void phase_quant_wq(const bf16_t* __restrict__ WqT, unsigned* __restrict__ Wq8, float* __restrict__ SW, int nrows) {
    const int tix = otid();
    const int lane = tix & 63, w = tix >> 6;
    for (int r0 = ((int)blockIdx.x * 8 + w) * 2; r0 < nrows; r0 += (int)gridDim.x * 16) {
        uint4 v[2][4];
#pragma unroll
        for (int k = 0; k < 2; ++k)
#pragma unroll
            for (int i = 0; i < 4; ++i) v[k][i] = *(const uint4*)(WqT + (size_t)(r0 + k) * 2048 + i * 512 + lane * 8);
#pragma unroll
        for (int k = 0; k < 2; ++k) { float f[4][8]; float m = 0.f;
#pragma unroll
            for (int i = 0; i < 4; ++i) { wq_bf8_to_f(v[k][i], f[i]);
#pragma unroll
                for (int j = 0; j < 8; ++j) m = fmaxf(m, fabsf(f[i][j])); }
#pragma unroll
            for (int o = 32; o >= 1; o >>= 1) m = fmaxf(m, __shfl_xor(m, o));
            const float sc = m > 0.f ? 127.0f / m : 0.f;
#pragma unroll
            for (int i = 0; i < 4; ++i) { unsigned q[2];
#pragma unroll
                for (int h = 0; h < 2; ++h) { const int a = (int)rintf(f[i][4 * h] * sc), b = (int)rintf(f[i][4 * h + 1] * sc), c = (int)rintf(f[i][4 * h + 2] * sc), d = (int)rintf(f[i][4 * h + 3] * sc);
                    q[h] = (unsigned)(a & 255) | ((unsigned)(b & 255) << 8) | ((unsigned)(c & 255) << 16) | ((unsigned)(d & 255) << 24); }
                *(uint2*)(Wq8 + (size_t)(r0 + k) * 512 + i * 128 + lane * 2) = make_uint2(q[0], q[1]); }
            if (lane == 0) SW[r0 + k] = m * (1.0f / 127.0f);
        }
    }
}

#define V8I_LOAD(RR, WQ, lbp, kk0) do { WQ = *(const u4q_t*)((lbp) + 512 + sub * 32 + (kk0)); \
        _Pragma("unroll") for (int j4 = 0; j4 < 4; ++j4) { const u4q_t eo = *(const u4q_t*)((lbp) + (sub * 32 + (kk0) + j4 * 4) * 4); \
        RR[j4 * 4 + 0] = *(const u4q_t*)(vb + (eo.x + lofs)); RR[j4 * 4 + 1] = *(const u4q_t*)(vb + (eo.y + lofs)); RR[j4 * 4 + 2] = *(const u4q_t*)(vb + (eo.z + lofs)); RR[j4 * 4 + 3] = *(const u4q_t*)(vb + (eo.w + lofs)); } } while (0)
#define V8I_T4(A_, B_, C_, D_, wq_, c0) do { const unsigned P_ = permb(B_, A_, 0x05010400u), Q_ = permb(B_, A_, 0x07030602u), R_ = permb(D_, C_, 0x05010400u), S_ = permb(D_, C_, 0x07030602u); \
        acc[(c0) + 0] = __builtin_amdgcn_sdot4((int)permb(R_, P_, 0x05040100u), (int)(wq_), acc[(c0) + 0], false); acc[(c0) + 1] = __builtin_amdgcn_sdot4((int)permb(R_, P_, 0x07060302u), (int)(wq_), acc[(c0) + 1], false); \
        acc[(c0) + 2] = __builtin_amdgcn_sdot4((int)permb(S_, Q_, 0x05040100u), (int)(wq_), acc[(c0) + 2], false); acc[(c0) + 3] = __builtin_amdgcn_sdot4((int)permb(S_, Q_, 0x07060302u), (int)(wq_), acc[(c0) + 3], false); } while (0)
#define V8I_COMP(RR, WQ) do { _Pragma("unroll") for (int j4 = 0; j4 < 4; ++j4) { const unsigned wq_ = (j4 == 0 ? WQ.x : (j4 == 1 ? WQ.y : (j4 == 2 ? WQ.z : WQ.w))); \
        V8I_T4(RR[j4 * 4].x, RR[j4 * 4 + 1].x, RR[j4 * 4 + 2].x, RR[j4 * 4 + 3].x, wq_, 0); V8I_T4(RR[j4 * 4].y, RR[j4 * 4 + 1].y, RR[j4 * 4 + 2].y, RR[j4 * 4 + 3].y, wq_, 4); \
        V8I_T4(RR[j4 * 4].z, RR[j4 * 4 + 1].z, RR[j4 * 4 + 2].z, RR[j4 * 4 + 3].z, wq_, 8); V8I_T4(RR[j4 * 4].w, RR[j4 * 4 + 1].w, RR[j4 * 4 + 2].w, RR[j4 * 4 + 3].w, wq_, 12); } } while (0)
__device__ __forceinline__ void phase_peer_fin(const float* __restrict__ G, const float* __restrict__ SUE, const int* __restrict__ ZI, const float* __restrict__ SX,
                                               unsigned char* __restrict__ WQ, float* __restrict__ WSC, unsigned short* __restrict__ E) {
    const int tix = otid();
    const int lane = tix & 63, w = tix >> 6;
    for (int t = blockIdx.x * 8 + w; t < T_; t += gridDim.x * 8) {
        int i0 = 0, i1 = 0;
#pragma unroll
        for (int x = 0; x < 8; ++x) { i0 += ZI[((size_t)x * T_ + t) * 128 + lane]; i1 += ZI[((size_t)x * T_ + t) * 128 + 64 + lane]; }
        const float sx = SX[t];
        const float z0 = (float)i0 * (SUE[(size_t)t * 128 + lane] * sx), z1 = (float)i1 * (SUE[(size_t)t * 128 + 64 + lane] * sx);
        const float w0 = gelu_exact(z0) * G[(size_t)t * 128 + lane], w1 = gelu_exact(z1) * G[(size_t)t * 128 + 64 + lane];
        float wm = fmaxf(fabsf(w0), fabsf(w1));
        wm = wave_max_f(wm);
        const float qs = wm > 0.f ? 127.0f / wm : 0.f;
        const int q0 = (int)rintf(w0 * qs), q1 = (int)rintf(w1 * qs);
        WQ[(size_t)t * 128 + lane] = (unsigned char)(q0 & 255); WQ[(size_t)t * 128 + 64 + lane] = (unsigned char)(q1 & 255);
        if (q0 == 0) E[(size_t)t * 128 + lane] = 0;
        if (q1 == 0) E[(size_t)t * 128 + 64 + lane] = 0;
        if (lane == 0) WSC[t] = wm * (1.0f / 127.0f);
    }
}
struct V8KPre { unsigned ew; unsigned wq; float wsc; };
#define V8K_PLOAD(P_, tt) do { P_.ew = ((const unsigned*)E)[(size_t)(tt) * 64 + lane]; P_.wq = ((const unsigned*)WQ)[(size_t)(tt) * 32 + (lane & 31)]; P_.wsc = WSC[(tt)]; } while (0)
#define V8K_PFIN(P_, bsel, wsc_out) do { unsigned char* lb_ = lds + w * 2048 + (bsel) * 1024; wsc_out = P_.wsc; \
        *(uint2*)(lb_ + 8 * lane) = make_uint2((P_.ew & 0xFFFFu) * 2048u, (P_.ew >> 16) * 2048u); if (lane < 32) ((unsigned*)(lb_ + 512))[lane] = P_.wq; } while (0)
__device__ __forceinline__ void phase_gather_v8k(bf16_t* __restrict__ YB, const unsigned* __restrict__ Vq, const unsigned short* __restrict__ E, const unsigned char* __restrict__ WQ, const float* __restrict__ WSC,
                                                 unsigned char* lds) {
    const int tix = otid();
    const int lane = tix & 63, w = tix >> 6, L = lane & 15, sub = lane >> 4;
    for (int vblk = blockIdx.x; vblk < 256; vblk += gridDim.x) {
    const int X = vblk & 7, r = vblk >> 3, nr = 32, step = nr * 8;
    const char* vb = (const char*)Vq + X * 256; const unsigned lofs = (unsigned)L * 16u;
    int t = r * 8 + w; int buf = 0;
    float wsc = 0.f, wscn = 0.f;
    V8KPre P0, P1;
    V8K_PLOAD(P0, t);
    { const int t1 = (t + step < T_) ? t + step : t; V8K_PLOAD(P1, t1); }
    V8K_PFIN(P0, 0, wsc);
    u4q_t RA[16], RB[16]; u4q_t WA, WB;
    V8I_LOAD(RA, WA, lds + w * 2048, 0);
#pragma unroll 1
    for (; t < T_; t += step) {
        const int t2 = (t + 2 * step < T_) ? t + 2 * step : t;
        const unsigned char* lbp = lds + w * 2048 + buf * 1024;
        V8I_LOAD(RB, WB, lbp, 16);
        V8K_PLOAD(P0, t2);
        int acc[16];
#pragma unroll
        for (int i = 0; i < 16; ++i) acc[i] = 0;
        V8I_COMP(RA, WA);
        V8K_PFIN(P1, buf ^ 1, wscn);
        V8I_LOAD(RA, WA, lds + w * 2048 + (buf ^ 1) * 1024, 0);
        V8I_COMP(RB, WB);
        int s1[8], f4[4];
#pragma unroll
        for (int i = 0; i < 8; ++i) { const auto r_ = __builtin_amdgcn_permlane32_swap((unsigned)acc[i], (unsigned)acc[i + 8], false, false); s1[i] = (int)r_[0] + (int)r_[1]; }
#pragma unroll
        for (int i = 0; i < 4; ++i) { const auto r_ = __builtin_amdgcn_permlane16_swap((unsigned)s1[i], (unsigned)s1[i + 4], false, false); f4[i] = (int)r_[0] + (int)r_[1]; }
        { const size_t o = (size_t)t * D_ + X * 256 + L * 16 + sub * 4;
          typedef unsigned u2nt_t __attribute__((ext_vector_type(2)));
          const u2nt_t n0 = {pack2bf(wsc * (float)f4[0], wsc * (float)f4[1]), pack2bf(wsc * (float)f4[2], wsc * (float)f4[3])};
          __builtin_nontemporal_store(n0, (u2nt_t*)(YB + o)); }
        buf ^= 1; wsc = wscn; P1 = P0;
    }
    }
}
struct U8RPre { unsigned ew; u4q_t xs; };
#define U8R_PLOAD(P_, tt) do { P_.ew = ((const unsigned*)E)[(size_t)(tt) * 64 + lane]; P_.xs = *(const u4q_t*)((const char*)x1q + (size_t)(tt) * 2048 + X * 256 + L * 16); } while (0)
#define U8R_STAGE(P_, bsel) do { unsigned* lb_ = (unsigned*)(lds + w * 1024 + (bsel) * 512); *(uint2*)(lb_ + 2 * lane) = make_uint2((P_.ew & 0xFFFFu) * 2048u, (P_.ew >> 16) * 2048u); } while (0)
#define U8R_LOAD(RR, bsel, kk0) do { const unsigned* lb_ = (const unsigned*)(lds + w * 1024 + (bsel) * 512) + sub * 32 + (kk0); _Pragma("unroll") for (int j4 = 0; j4 < 4; ++j4) { const u4q_t eo = *(const u4q_t*)(lb_ + j4 * 4); \
        RR[j4 * 4 + 0] = *(const u4q_t*)(ub + eo.x); RR[j4 * 4 + 1] = *(const u4q_t*)(ub + eo.y); RR[j4 * 4 + 2] = *(const u4q_t*)(ub + eo.z); RR[j4 * 4 + 3] = *(const u4q_t*)(ub + eo.w); } } while (0)
__device__ __forceinline__ void phase_gather_u8r(const unsigned* __restrict__ x1q, const unsigned* __restrict__ Uq, const unsigned short* __restrict__ E, int* __restrict__ ZI, unsigned char* lds) {
    const int tix = otid();
    const int lane = tix & 63, w = tix >> 6, L = lane & 15, sub = lane >> 4;
    for (int vb = blockIdx.x; vb < 256; vb += gridDim.x) {
    const int X = vb & 7, r = vb >> 3, nr = 32, step = nr * 8;
    const char* ub = (const char*)Uq + X * 256 + L * 16;
    int t = r * 8 + w; int buf = 0;
    U8RPre P0, P1;
    U8R_PLOAD(P0, t);
    { const int t1 = (t + step < T_) ? t + step : t; U8R_PLOAD(P1, t1); }
    U8R_STAGE(P0, 0);
    u4q_t xs = P0.xs, xsn = P1.xs;
    u4q_t RA[16], RB[16];
    U8R_LOAD(RA, 0, 0);
#pragma unroll 1
    for (; t < T_; t += step) {
        const int t2 = (t + 2 * step < T_) ? t + 2 * step : t;
        U8R_LOAD(RB, buf, 16);
        U8R_PLOAD(P0, t2);
        int zA = 0, zB = 0;
        U8_COMP(RA, xs, zA);
        U8R_STAGE(P1, buf ^ 1);
        U8R_LOAD(RA, buf ^ 1, 0);
        U8_COMP(RB, xs, zB);
        int* zp = ZI + ((size_t)X * T_ + t) * 128 + sub * 32 + L;
        __builtin_nontemporal_store(zA, zp); __builtin_nontemporal_store(zB, zp + 16);
        buf ^= 1; xs = xsn; xsn = P0.xs; P1 = P0;
    }
    }
}
struct U4Pre { unsigned ew; u4q_t xa, xb; };
#define U4_PLOAD(P_, tt) do { P_.ew = ((const unsigned*)E)[(size_t)(tt) * 64 + lane]; const char* xp_ = (const char*)x1q + (size_t)(tt) * 2048 + X * 256 + L8 * 32; \
        P_.xa = *(const u4q_t*)xp_; P_.xb = *(const u4q_t*)(xp_ + 16); } while (0)
#define U4_STAGE(P_, bsel) do { unsigned* lb_ = (unsigned*)(lds + w * 1024 + (bsel) * 512); *(uint2*)(lb_ + 2 * lane) = make_uint2((P_.ew & 0xFFFFu) * 1024u, (P_.ew >> 16) * 1024u); } while (0)
#define U4_LOAD(RR, bsel) do { const unsigned* lb_ = (const unsigned*)(lds + w * 1024 + (bsel) * 512) + sub * 16; _Pragma("unroll") for (int j4 = 0; j4 < 4; ++j4) { const u4q_t eo = *(const u4q_t*)(lb_ + j4 * 4); \
        RR[j4 * 4 + 0] = *(const u4q_t*)(ub + (eo.x + lofs)); RR[j4 * 4 + 1] = *(const u4q_t*)(ub + (eo.y + lofs)); RR[j4 * 4 + 2] = *(const u4q_t*)(ub + (eo.z + lofs)); RR[j4 * 4 + 3] = *(const u4q_t*)(ub + (eo.w + lofs)); } } while (0)
#define U4_PLANE1(X0_, X1_, H_, L_) do { const unsigned s0_ = (((X0_) & 0x7F7F7F7Fu) + 0x08080808u) ^ ((X0_) & 0x80808080u), s1_ = (((X1_) & 0x7F7F7F7Fu) + 0x08080808u) ^ ((X1_) & 0x80808080u); \
        H_ = ((s0_ >> 4) & 0x0F0F0F0Fu) | (s1_ & 0xF0F0F0F0u); L_ = ((X0_) & 0x0F0F0F0Fu) | (((X1_) & 0x0F0F0F0Fu) << 4); } while (0)
#define U4_COMP(RR, xa_, xb_, zA_, zB_) do { \
        unsigned H0_, H1_, H2_, H3_, L0_, L1_, L2_, L3_; U4_PLANE1(xa_.x, xa_.y, H0_, L0_); U4_PLANE1(xa_.z, xa_.w, H1_, L1_); U4_PLANE1(xb_.x, xb_.y, H2_, L2_); U4_PLANE1(xb_.z, xb_.w, H3_, L3_); \
        int d_[16]; \
        _Pragma("unroll") for (int j = 0; j < 16; ++j) { \
            int dh = __builtin_amdgcn_sdot8((int)RR[j].x, (int)H0_, 0, false), dl = __builtin_amdgcn_sdot8((int)RR[j].x, (int)L0_, 0, false); \
            dh = __builtin_amdgcn_sdot8((int)RR[j].y, (int)H1_, dh, false); dl = __builtin_amdgcn_sdot8((int)RR[j].y, (int)L1_, dl, false); \
            dh = __builtin_amdgcn_sdot8((int)RR[j].z, (int)H2_, dh, false); dl = __builtin_amdgcn_sdot8((int)RR[j].z, (int)L2_, dl, false); \
            dh = __builtin_amdgcn_sdot8((int)RR[j].w, (int)H3_, dh, false); dl = __builtin_amdgcn_sdot8((int)RR[j].w, (int)L3_, dl, false); d_[j] = (dh << 4) + dl; } \
          \
        _Pragma("unroll") for (int h = 0; h < 16; h += 8) { \
            _Pragma("unroll") for (int j = 0; j < 4; ++j) { const int kp = (L8 & 4) ? d_[h + j + 4] : d_[h + j], gv = (L8 & 4) ? d_[h + j] : d_[h + j + 4]; d_[h + j] = kp + dpp_i<0x141>(gv); } \
            _Pragma("unroll") for (int j = 0; j < 2; ++j) { const int kp = (L8 & 2) ? d_[h + j + 2] : d_[h + j], gv = (L8 & 2) ? d_[h + j] : d_[h + j + 2]; d_[h + j] = kp + dpp_i<0x4E>(gv); } \
            { const int kp = (L8 & 1) ? d_[h + 1] : d_[h], gv = (L8 & 1) ? d_[h] : d_[h + 1]; d_[h] = kp + dpp_i<0xB1>(gv); } } \
        zA_ = d_[0]; zB_ = d_[8]; } while (0)
__device__ __forceinline__ void phase_gather_u4(const unsigned* __restrict__ x1q, const unsigned* __restrict__ Uq, const unsigned short* __restrict__ E, int* __restrict__ ZI, unsigned char* lds) {
    const int tix = otid();
    const int lane = tix & 63, w = tix >> 6, L8 = lane & 7, sub = lane >> 3;
    for (int vb = blockIdx.x; vb < 256; vb += gridDim.x) {
    const int X = vb & 7, r = vb >> 3, step = 256;
    const char* ub = (const char*)Uq + X * 128; const unsigned lofs = (unsigned)L8 * 16u;
    const int t0 = r * 8 + w;
    U4Pre P0, P1;
    U4_PLOAD(P0, t0); U4_PLOAD(P1, t0 + step);
    U4_STAGE(P0, 0);
    u4q_t RA[16], RB[16];
    U4_LOAD(RA, 0);
    u4q_t xAa = P0.xa, xAb = P0.xb;
#pragma unroll 1
    for (int k = 0; k < 32; k += 2) {
        const int tA = t0 + step * k, tB = tA + step;
        U4_STAGE(P1, 1); U4_LOAD(RB, 1);
        const u4q_t xBa = P1.xa, xBb = P1.xb;
        U4_PLOAD(P0, t0 + step * min(k + 2, 31));
        { int zA = 0, zB = 0; U4_COMP(RA, xAa, xAb, zA, zB);
          int* zp = ZI + ((size_t)X * T_ + tA) * 128 + sub * 16 + L8; __builtin_nontemporal_store(zA, zp); __builtin_nontemporal_store(zB, zp + 8); }
        U4_STAGE(P0, 0); U4_LOAD(RA, 0);
        xAa = P0.xa; xAb = P0.xb;
        U4_PLOAD(P1, t0 + step * min(k + 3, 31));
        { int zA = 0, zB = 0; U4_COMP(RB, xBa, xBb, zA, zB);
          int* zp = ZI + ((size_t)X * T_ + tB) * 128 + sub * 16 + L8; __builtin_nontemporal_store(zA, zp); __builtin_nontemporal_store(zB, zp + 8); }
    }
    }
}
__device__ __forceinline__ void phase_cvt_gatew(const float* __restrict__ wr, const float* __restrict__ wi, bf16_t* __restrict__ Wt, int bid, int nb_) {
    const int tix = otid();
    const int total = 2 * 2 * 8 * 2 * 128 * 128;
    for (int o = bid * NTHR + tix; o < total; o += nb_ * NTHR) {
        const int i = o & 127, j = (o >> 7) & 127, gate = (o >> 14) & 1, dh = (o >> 15) & 15, il = o >> 19;
        const float* src = gate ? wi : wr;
        Wt[o] = f2bf(src[(((size_t)il * 16 + dh) * 128 + i) * 128 + j]);
    }
}

#define EV_AS   0
#define EV_US   33792
#define EV_XS   0
#define EV_XCF  67584
#define EV_XCB  101376
#define EV_SEG  118784
#define EV_ROWF 132
#define EV_ROWB 272
__device__ __forceinline__ void phase_even_local(const bf16_t* __restrict__ Z, const float* __restrict__ cw  , const float* __restrict__ cb  ,
                                                 const bf16_t* __restrict__ Wt  , const float* __restrict__ br, const float* __restrict__ bi, const float* __restrict__ lam,
                                                 bf16_t* __restrict__ HL, bf16_t* __restrict__ CA, float* __restrict__ AGG, unsigned char* lds, int u0, int u1, int ustep) {
    const int tix = otid();
    const int lane = tix & 63, w = tix >> 6, tokl = lane & 15, g = lane >> 4;
    float* AS = (float*)(lds + EV_AS); float* US = (float*)(lds + EV_US); float* XS = (float*)(lds + EV_XS); float* XCF = (float*)(lds + EV_XCF);
    float* SEG = (float*)(lds + EV_SEG);
    uint4 pre[3];
#define EVL_PREFETCH(uu) do { const int dh_ = (uu) & 15, d_ = dh_ >> 3, h_ = dh_ & 7, c_ = (uu) >> 4; const int tb_ = d_ == 0 ? c_ * 64 - 3 : c_ * 64; \
        _Pragma("unroll") for (int i_ = 0; i_ < 3; ++i_) { const int idx_ = tix + i_ * NTHR; const int r_ = idx_ >> 4, c8_ = idx_ & 15; const int tt_ = tb_ + r_; \
            pre[i_] = make_uint4(0u, 0u, 0u, 0u); if (idx_ < 67 * 16 && tt_ >= 0 && tt_ < T_) pre[i_] = *(const uint4*)(Z + (size_t)tt_ * NZ_ + 3072 + h_ * 128 + c8_ * 8); } } while (0)
    int cur_dh = -1, cur_dhc = -1; pg8::bf16x8 af[2][4]; float sp[4], brr[4], bii[4]; float4 w0, w1, w2, w3, bb;
    if (u0 < u1) EVL_PREFETCH(u0);
    for (int u = u0; u < u1; u += ustep) {
        const int dh = u & 15, d = dh >> 3, h = dh & 7, c = u >> 4, t0 = c * 64;
        __syncthreads();
#pragma unroll
        for (int i = 0; i < 3; ++i) { const int idx = tix + i * NTHR; const int r = idx >> 4, c8 = idx & 15; const uint4 v = pre[i];
            if (idx < 67 * 16) {
                *(float4*)(XS + r * 128 + c8 * 8) = make_float4(__uint_as_float(v.x << 16), __uint_as_float(v.x & 0xffff0000u), __uint_as_float(v.y << 16), __uint_as_float(v.y & 0xffff0000u));
                *(float4*)(XS + r * 128 + c8 * 8 + 4) = make_float4(__uint_as_float(v.z << 16), __uint_as_float(v.z & 0xffff0000u), __uint_as_float(v.w << 16), __uint_as_float(v.w & 0xffff0000u)); } }
        if (u + ustep < u1) EVL_PREFETCH(u + ustep);
        __syncthreads();
        float4 xcv[4];
        { const int c4 = tix & 31, tg = tix >> 5; const int ch = h * 128 + c4 * 4;
          if (dh != cur_dhc) { cur_dhc = dh; w0 = *(const float4*)(cw + (d * 4 + 0) * 1024 + ch); w1 = *(const float4*)(cw + (d * 4 + 1) * 1024 + ch); w2 = *(const float4*)(cw + (d * 4 + 2) * 1024 + ch);
              w3 = *(const float4*)(cw + (d * 4 + 3) * 1024 + ch); bb = *(const float4*)(cb + d * 1024 + ch); }
          float4 xr[7];
#pragma unroll
          for (int r = 0; r < 7; ++r) xr[r] = *(const float4*)(XS + (tg * 4 + r) * 128 + c4 * 4);
#pragma unroll
          for (int k = 0; k < 4; ++k) { float4 o;
              o.x = bb.x + w0.x * xr[k].x + w1.x * xr[k + 1].x + w2.x * xr[k + 2].x + w3.x * xr[k + 3].x;
              o.y = bb.y + w0.y * xr[k].y + w1.y * xr[k + 1].y + w2.y * xr[k + 2].y + w3.y * xr[k + 3].y;
              o.z = bb.z + w0.z * xr[k].z + w1.z * xr[k + 1].z + w2.z * xr[k + 2].z + w3.z * xr[k + 3].z;
              o.w = bb.w + w0.w * xr[k].w + w1.w * xr[k + 1].w + w2.w * xr[k + 2].w + w3.w * xr[k + 3].w;
              xcv[k] = o; }
          __syncthreads();
#pragma unroll
          for (int k = 0; k < 4; ++k) { const int tl = tg * 4 + k;
              *(float4*)(XCF + tl * EV_ROWF + c4 * 4) = xcv[k];
              uint2 pk; pk.x = pack2bf(xcv[k].x, xcv[k].y); pk.y = pack2bf(xcv[k].z, xcv[k].w);
              *(uint2*)(lds + EV_XCB + tl * EV_ROWB + c4 * 8) = pk; } }
        __syncthreads();
        { if (dh != cur_dh) { cur_dh = dh;
              const bf16_t* wbase = Wt + ((size_t)(dh * 2) * 128 + w * 16 + tokl) * 128 + g * 8;
#pragma unroll
              for (int gt = 0; gt < 2; ++gt)
#pragma unroll
                  for (int ks = 0; ks < 4; ++ks) af[gt][ks] = *(const pg8::bf16x8*)(wbase + (size_t)gt * 128 * 128 + ks * 32);
              const int ch0 = h * 128 + w * 16 + g * 4;
              const float4 brv = *(const float4*)(br + d * 1024 + ch0), biv = *(const float4*)(bi + d * 1024 + ch0), lmv = *(const float4*)(lam + d * 1024 + ch0);
              sp[0] = log1pf(expf(-lmv.x)); sp[1] = log1pf(expf(-lmv.y)); sp[2] = log1pf(expf(-lmv.z)); sp[3] = log1pf(expf(-lmv.w));
              brr[0] = brv.x; brr[1] = brv.y; brr[2] = brv.z; brr[3] = brv.w; bii[0] = biv.x; bii[1] = biv.y; bii[2] = biv.z; bii[3] = biv.w; }
#pragma unroll
          for (int nt = 0; nt < 4; ++nt) {
              pg8::f32x4 accr = {0.f, 0.f, 0.f, 0.f}, acci = {0.f, 0.f, 0.f, 0.f};
#pragma unroll
              for (int ks = 0; ks < 4; ++ks) { const pg8::bf16x8 b = *(const pg8::bf16x8*)(lds + EV_XCB + (nt * 16 + tokl) * EV_ROWB + (ks * 32 + g * 8) * 2);
                  accr = __builtin_amdgcn_mfma_f32_16x16x32_bf16(af[0][ks], b, accr, 0, 0, 0);
                  acci = __builtin_amdgcn_mfma_f32_16x16x32_bf16(af[1][ks], b, acci, 0, 0, 0); }
              const int tl = nt * 16 + tokl;
              const float4 xv = *(const float4*)(XCF + tl * EV_ROWF + w * 16 + g * 4);
              const float xx[4] = {xv.x, xv.y, xv.z, xv.w};
              float av[4], uv[4];
#pragma unroll
              for (int r = 0; r < 4; ++r) {
                  const float rg = __builtin_amdgcn_rcpf(1.0f + __builtin_amdgcn_exp2f(-1.4426950408889634f * (accr[r] + brr[r])));
                  const float ig = __builtin_amdgcn_rcpf(1.0f + __builtin_amdgcn_exp2f(-1.4426950408889634f * (acci[r] + bii[r])));
                  const float a_ = __builtin_amdgcn_exp2f(-8.0f * 1.4426950408889634f * rg * sp[r]);
                  av[r] = a_; uv[r] = __builtin_amdgcn_sqrtf(fmaxf(fmaf(-a_, a_, 1.0f), 0.f)) * ig * xx[r]; }
              *(float4*)(AS + tl * EV_ROWF + w * 16 + g * 4) = make_float4(av[0], av[1], av[2], av[3]);
              *(float4*)(US + tl * EV_ROWF + w * 16 + g * 4) = make_float4(uv[0], uv[1], uv[2], uv[3]);
              __builtin_amdgcn_sched_barrier(0);
          } }
        __syncthreads();
        { const int c2 = (tix & 63) * 2, seg = tix >> 6;
          float2 av[8], uv[8];
#pragma unroll
          for (int k = 0; k < 8; ++k) { const int s = seg * 8 + k; const int tl = d == 0 ? s : 63 - s; av[k] = *(const float2*)(AS + tl * EV_ROWF + c2); uv[k] = *(const float2*)(US + tl * EV_ROWF + c2); }
          float2 hh = {0.f, 0.f}, P = {1.f, 1.f};
#pragma unroll
          for (int k = 0; k < 8; ++k) { hh.x = av[k].x * hh.x + uv[k].x; hh.y = av[k].y * hh.y + uv[k].y; P.x *= av[k].x; P.y *= av[k].y; uv[k] = hh; av[k] = P; }
          *(float2*)(SEG + seg * 128 + c2) = P; *(float2*)(SEG + 1024 + seg * 128 + c2) = hh;
          __syncthreads();
          float2 Hc = {0.f, 0.f}, Pc = {1.f, 1.f};
          for (int q = 0; q < seg; ++q) { const float2 a = *(const float2*)(SEG + q * 128 + c2), hq = *(const float2*)(SEG + 1024 + q * 128 + c2);
              Hc.x = a.x * Hc.x + hq.x; Hc.y = a.y * Hc.y + hq.y; Pc.x *= a.x; Pc.y *= a.y; }
          float2 hl = {0.f, 0.f}, pl = {1.f, 1.f};
#pragma unroll
          for (int k = 0; k < 8; ++k) { const int s = seg * 8 + k; const int tl = d == 0 ? s : 63 - s;
              hl.x = uv[k].x + av[k].x * Hc.x; hl.y = uv[k].y + av[k].y * Hc.y; pl.x = av[k].x * Pc.x; pl.y = av[k].y * Pc.y;
              const size_t o = ((size_t)d * T_ + t0 + tl) * 1024 + h * 128 + c2;
              *(unsigned*)(HL + o) = pack2bf(hl.x, hl.y); *(unsigned*)(CA + o) = pack2bf(pl.x, pl.y); }
          if (seg == 7) { const float4 ag = {pl.x, hl.x, pl.y, hl.y}; *(float4*)(AGG + (((size_t)d * 128 + c) * 1024 + h * 128 + c2) * 2) = ag; } }
    }
}

__device__ __forceinline__ void phase_even_carry(const float* __restrict__ AGG, float* __restrict__ CARRY) {
    const int tix = otid();
    const int lane = tix & 63, w = tix >> 6;
    for (int id = blockIdx.x * 8 + w; id < 2048; id += gridDim.x * 8) {
        const int ch = id & 1023, d = id >> 10;
        const int c0 = d == 0 ? 2 * lane : 127 - 2 * lane, c1 = d == 0 ? c0 + 1 : c0 - 1;
        const float2 g0 = *(const float2*)(AGG + (((size_t)d * 128 + c0) * 1024 + ch) * 2), g1 = *(const float2*)(AGG + (((size_t)d * 128 + c1) * 1024 + ch) * 2);
        float a = g0.x * g1.x, h = g1.x * g0.y + g1.y;
#pragma unroll
        for (int off = 1; off < 64; off <<= 1) { const float pa = __shfl_up(a, off), ph = __shfl_up(h, off); if (lane >= off) { h = a * ph + h; a = pa * a; } }
        float cin = __shfl_up(h, 1); if (lane == 0) cin = 0.f;
        CARRY[((size_t)d * 128 + c0) * 1024 + ch] = cin;
        CARRY[((size_t)d * 128 + c1) * 1024 + ch] = g0.x * cin + g0.y;
    }
}

__device__ __forceinline__ void bf8_to_f(const uint4 v, float (&f)[8]) {
    f[0] = __uint_as_float(v.x << 16); f[1] = __uint_as_float(v.x & 0xffff0000u); f[2] = __uint_as_float(v.y << 16); f[3] = __uint_as_float(v.y & 0xffff0000u);
    f[4] = __uint_as_float(v.z << 16); f[5] = __uint_as_float(v.z & 0xffff0000u); f[6] = __uint_as_float(v.w << 16); f[7] = __uint_as_float(v.w & 0xffff0000u); }
struct MixIn { uint2 gcm, xam, gc0, xa0, gcp, xap, gb, gg, h0, p0, h1, p1; float4 c0, c1; };
__device__ __forceinline__ void bf4_to_f(const uint2 v, float (&f)[4]) { f[0] = __uint_as_float(v.x << 16); f[1] = __uint_as_float(v.x & 0xffff0000u); f[2] = __uint_as_float(v.y << 16); f[3] = __uint_as_float(v.y & 0xffff0000u); }
__device__ __forceinline__ void mix_load(MixIn& m, const bf16_t* __restrict__ Z, const bf16_t* __restrict__ HL, const bf16_t* __restrict__ CA, const float* __restrict__ CARRY, int t, int c) {
    const bf16_t* zr = Z + (size_t)t * NZ_;
    const uint2 z2 = make_uint2(0u, 0u);
    m.gcm = z2; m.xam = z2; m.gcp = z2; m.xap = z2;
    if (t > 0) { m.gcm = *(const uint2*)(zr - NZ_ + 1024 + c); m.xam = *(const uint2*)(zr - NZ_ + 2048 + c); }
    m.gc0 = *(const uint2*)(zr + 1024 + c); m.xa0 = *(const uint2*)(zr + 2048 + c);
    if (t < T_ - 1) { m.gcp = *(const uint2*)(zr + NZ_ + 1024 + c); m.xap = *(const uint2*)(zr + NZ_ + 2048 + c); }
    m.gb = *(const uint2*)(zr + c); m.gg = *(const uint2*)(zr + 4096 + c);
    const int ck = t >> 6;
    const size_t o0 = (size_t)t * 1024 + c, o1 = ((size_t)T_ + t) * 1024 + c;
    m.h0 = *(const uint2*)(HL + o0); m.p0 = *(const uint2*)(CA + o0); m.h1 = *(const uint2*)(HL + o1); m.p1 = *(const uint2*)(CA + o1);
    m.c0 = *(const float4*)(CARRY + (size_t)ck * 1024 + c); m.c1 = *(const float4*)(CARRY + ((size_t)128 + ck) * 1024 + c);
}
__device__ __forceinline__ void phase_even_mix(const bf16_t* __restrict__ Z, const float* __restrict__ ca  , const bf16_t* __restrict__ HL, const bf16_t* __restrict__ CA,
                                               const float* __restrict__ CARRY, bf16_t* __restrict__ Y) {
    const int tix = otid();
    const int c = (tix & 255) * 4, sub = tix >> 8;
    const float4 q0 = *(const float4*)(ca + c), q1 = *(const float4*)(ca + 1024 + c), q2 = *(const float4*)(ca + 2048 + c);
    const float k0[4] = {q0.x, q0.y, q0.z, q0.w}, k1[4] = {q1.x, q1.y, q1.z, q1.w}, k2[4] = {q2.x, q2.y, q2.z, q2.w};
    const int step = gridDim.x * 2;
    int t = blockIdx.x * 2 + sub;
    MixIn cur, nxt;
    if (t < T_) mix_load(cur, Z, HL, CA, CARRY, t, c);
    for (; t < T_; t += step) {
        const int tn = (t + step < T_) ? t + step : t;
        mix_load(nxt, Z, HL, CA, CARRY, tn, c);
        float s[4], a[4], b[4];
        bf4_to_f(cur.gcm, a); bf4_to_f(cur.xam, b);
#pragma unroll
        for (int i = 0; i < 4; ++i) s[i] = k0[i] * a[i] * b[i];
        bf4_to_f(cur.gc0, a); bf4_to_f(cur.xa0, b);
#pragma unroll
        for (int i = 0; i < 4; ++i) s[i] += k1[i] * a[i] * b[i];
        bf4_to_f(cur.gcp, a); bf4_to_f(cur.xap, b);
#pragma unroll
        for (int i = 0; i < 4; ++i) s[i] += k2[i] * a[i] * b[i];
        float gb[4], gg[4], h0[4], p0[4], h1[4], p1[4];
        bf4_to_f(cur.gb, gb); bf4_to_f(cur.gg, gg); bf4_to_f(cur.h0, h0); bf4_to_f(cur.p0, p0); bf4_to_f(cur.h1, h1); bf4_to_f(cur.p1, p1);
        const float cf[4] = {cur.c0.x, cur.c0.y, cur.c0.z, cur.c0.w}, cbw[4] = {cur.c1.x, cur.c1.y, cur.c1.z, cur.c1.w};
        float ya[4], yb[4];
#pragma unroll
        for (int i = 0; i < 4; ++i) { ya[i] = gb[i] * s[i]; yb[i] = gelu_exact(gg[i]) * (h0[i] + p0[i] * cf[i] + h1[i] + p1[i] * cbw[i]); }
        uint2 oa, ob;
        oa.x = pack2bf(ya[0], ya[1]); oa.y = pack2bf(ya[2], ya[3]); ob.x = pack2bf(yb[0], yb[1]); ob.y = pack2bf(yb[2], yb[3]);
        *(uint2*)(Y + (size_t)t * D_ + c) = oa; *(uint2*)(Y + (size_t)t * D_ + 1024 + c) = ob;
        cur = nxt;
    }
}
__device__ __forceinline__ int at3_fk(int R) { return (R & 3) | (((R >> 3) & 3) << 2); }
#define AT5_BIAS 131072
struct At5Lane { unsigned koff, voff; int vsel; };
__device__ __forceinline__ At5Lane at5_lane(int w, int lane) {
    const int rr = lane >> 4, pc = lane & 15, R0 = 4 * w + rr; At5Lane c;
    c.koff = (unsigned)R0 * 4096u + (unsigned)((pc ^ at3_fk(R0)) << 3);
    const int gpiece = pc ^ (R0 & 15);
    c.voff = (unsigned)R0 * (unsigned)T_ + (unsigned)((gpiece & 7) << 3); c.vsel = gpiece >> 3; return c;
}
__device__ __forceinline__ void at5_issue(const bf16_t* __restrict__ QK, const bf16_t* __restrict__ Vt, PG8_LAS unsigned char* ll, int unit, int s, int buf, int w, const At5Lane& c) {
    const int r0 = (unit >> 4) * 2, h = unit & 15;
    const int lo = min(max(r0 - 4, 0), NROWS_ - 8);
    const int k0 = min(lo + 2 * s, NROWS_ - 1), k1 = min(lo + 2 * s + 1, NROWS_ - 1);
    const bf16_t* kb0 = QK + (size_t)k0 * 64 * 4096 + 2048 + h * 128 + c.koff; const bf16_t* kb1 = QK + (size_t)k1 * 64 * 4096 + 2048 + h * 128 + c.koff;
    __builtin_amdgcn_global_load_lds((const unsigned*)kb0, (PG8_LAS unsigned*)(ll + buf * 65536 + (0 * 8 + w) * 1024), 16, 0, 0);
    __builtin_amdgcn_global_load_lds((const unsigned*)(kb0 + 32 * 4096), (PG8_LAS unsigned*)(ll + buf * 65536 + (1 * 8 + w) * 1024), 16, 0, 0);
    __builtin_amdgcn_global_load_lds((const unsigned*)kb1, (PG8_LAS unsigned*)(ll + buf * 65536 + (2 * 8 + w) * 1024), 16, 0, 0);
    __builtin_amdgcn_global_load_lds((const unsigned*)(kb1 + 32 * 4096), (PG8_LAS unsigned*)(ll + buf * 65536 + (3 * 8 + w) * 1024), 16, 0, 0);
    const bf16_t* vb = Vt + (size_t)h * 128 * T_ + c.voff + (c.vsel ? k1 : k0) * 64;
#pragma unroll
    for (int i = 0; i < 4; ++i) __builtin_amdgcn_global_load_lds((const unsigned*)(vb + (size_t)i * 32 * T_), (PG8_LAS unsigned*)(ll + buf * 65536 + 32768 + (i * 8 + w) * 1024), 16, 0, 0);
}
struct At5Stage { const float* rb; unsigned char* lds;
    __device__ __forceinline__ void operator()(int i0) const { float* bl = (float*)(lds + AT5_BIAS); for (int i = i0; i < 16 * 465; i += NTHR - 64) bl[i] = rb[i]; } };
__device__ __forceinline__ void phase_attn5(const bf16_t* __restrict__ QK, const bf16_t* __restrict__ Vt, const float* __restrict__ rb, bf16_t* __restrict__ O, unsigned char* lds) {
    const int tix = otid();
    const int lane = tix & 63, w = __builtin_amdgcn_readfirstlane(tix >> 6), tokl = lane & 15, g = lane >> 4;
    const int j = w & 3, qrow = w >> 2;
    const int w0 = j == 0 ? 0 : (j == 1 ? 8 : (j == 2 ? 24 : 32));
    const int cq = 16 * j + tokl;
    const int cs = min(max(cq - 8, 0), GW_ - 16);
    float* bl = (float*)(lds + AT5_BIAS);
    const int kap = 8 * (tokl >> 2) + (tokl & 3);
    int cof[8]; float madd[8];
#pragma unroll
    for (int i = 0; i < 8; ++i) { const int kc = w0 + 8 * g + i; cof[i] = min(max(kc - cq, -15), 15) + 15; madd[i] = ((kc >= cs) && (kc < cs + 16)) ? 0.f : -INFINITY; }
    PG8_LAS unsigned char* ll = (PG8_LAS unsigned char*)lds;
    const int nmy = (1024 - (int)blockIdx.x + (int)gridDim.x - 1) / (int)gridDim.x;
    int buf = 0;
    const At5Lane lc = at5_lane(w, lane);
    if (nmy > 0) at5_issue(QK, Vt, ll, blockIdx.x, 0, 0, w, lc);
    pg8::bf16x8 bqn[4];
    { const int u0 = min((int)blockIdx.x, 1023); const int tq0 = ((u0 >> 4) * 2 + qrow) * 64 + cq;
#pragma unroll
      for (int ks = 0; ks < 4; ++ks) bqn[ks] = *(const pg8::bf16x8*)(QK + (size_t)tq0 * 4096 + (u0 & 15) * 128 + ks * 32 + g * 8); }
#pragma unroll 1
    for (int ku = 0; ku < nmy; ++ku) {
        const int unit = blockIdx.x + ku * gridDim.x;
        const int r0 = (unit >> 4) * 2, h = unit & 15;
        const int lo = min(max(r0 - 4, 0), NROWS_ - 8);
        const int r = r0 + qrow;
        const int rs = min(max(r - 4, 0), NROWS_ - 8);
        const int tq = r * 64 + cq;
        pg8::bf16x8 bq[4];
#pragma unroll
        for (int ks = 0; ks < 4; ++ks) bq[ks] = bqn[ks];
        float mrun = -INFINITY, l = 0.f;
        pg8::f32x4 Oa[8];
#pragma unroll
        for (int dt = 0; dt < 8; ++dt) Oa[dt] = (pg8::f32x4){0.f, 0.f, 0.f, 0.f};
        const float* bhead = bl + h * 465;
#pragma unroll 1
        for (int s = 0; s < 5; ++s) {
            asm volatile("s_waitcnt vmcnt(0)" ::: "memory");
            __syncthreads();
            if (s < 4) at5_issue(QK, Vt, ll, unit, s + 1, buf ^ 1, w, lc);
            else if (ku + 1 < nmy) { at5_issue(QK, Vt, ll, unit + gridDim.x, 0, buf ^ 1, w, lc);
                const int un = unit + gridDim.x; const int tqn = ((un >> 4) * 2 + qrow) * 64 + cq;
#pragma unroll
                for (int ks = 0; ks < 4; ++ks) bqn[ks] = *(const pg8::bf16x8*)(QK + (size_t)tqn * 4096 + (un & 15) * 128 + ks * 32 + g * 8); }
            const unsigned char* kb = lds + buf * 65536; const unsigned char* vbp = kb + 32768;
            pg8::f32x4 S[4];
#pragma unroll
            for (int krl = 0; krl < 2; ++krl)
#pragma unroll
                for (int hf = 0; hf < 2; ++hf) { const int R = krl * 64 + w0 + kap + 4 * hf; const int fk = at3_fk(R);
                    pg8::f32x4 acc = {0.f, 0.f, 0.f, 0.f};
#pragma unroll
                    for (int ks = 0; ks < 4; ++ks) { const pg8::bf16x8 a = *(const pg8::bf16x8*)(kb + R * 256 + (((ks * 4 + g) ^ fk) << 4)); acc = __builtin_amdgcn_mfma_f32_16x16x32_bf16(a, bq[ks], acc, 0, 0, 0); }
                    S[krl * 2 + hf] = acc; }
            float ms = -INFINITY;
#pragma unroll
            for (int krl = 0; krl < 2; ++krl) { const int krow = lo + 2 * s + krl; const bool rok = (krow >= rs) && (krow < rs + 8);
                const float rmask = rok ? 0.f : -INFINITY;
                const float* brow = bhead + min(max(krow - r + 7, 0), 14) * 31;
#pragma unroll
                for (int hf = 0; hf < 2; ++hf)
#pragma unroll
                    for (int q = 0; q < 4; ++q) { const float sv = fmaf(S[krl * 2 + hf][q], 0.08838834764831845f, brow[cof[hf * 4 + q]]) + (madd[hf * 4 + q] + rmask);
                        S[krl * 2 + hf][q] = sv; ms = fmaxf(ms, sv); } }
            ms = rows4_max(ms);
            const float mnew = fmaxf(mrun, ms);
            const float sc = __expf(mrun - mnew);
            mrun = mnew;
            l *= sc;
#pragma unroll
            for (int dt = 0; dt < 8; ++dt) { Oa[dt][0] *= sc; Oa[dt][1] *= sc; Oa[dt][2] *= sc; Oa[dt][3] *= sc; }
            pg8::bf16x8 pf[2];
#pragma unroll
            for (int krl = 0; krl < 2; ++krl) { float e[8];
#pragma unroll
                for (int hf = 0; hf < 2; ++hf)
#pragma unroll
                    for (int q = 0; q < 4; ++q) { const float pv = __expf(S[krl * 2 + hf][q] - mnew); e[hf * 4 + q] = pv; l += pv; }
                typedef unsigned u4v __attribute__((ext_vector_type(4)));
                u4v pk; pk.x = pack2bf(e[0], e[1]); pk.y = pack2bf(e[2], e[3]); pk.z = pack2bf(e[4], e[5]); pk.w = pack2bf(e[6], e[7]);
                pf[krl] = __builtin_bit_cast(pg8::bf16x8, pk); }
#pragma unroll
            for (int krl = 0; krl < 2; ++krl)
#pragma unroll
                for (int dt = 0; dt < 8; ++dt) { const int q = krl * 8 + (w0 >> 3) + g;
                    const pg8::bf16x8 a = *(const pg8::bf16x8*)(vbp + (dt * 16 + tokl) * 256 + ((q ^ tokl) << 4));
                    Oa[dt] = __builtin_amdgcn_mfma_f32_16x16x32_bf16(a, pf[krl], Oa[dt], 0, 0, 0); }
            buf ^= 1;
        }
        l = rows4_sum(l);
        const float inv = 1.0f / l;
        bf16_t* op = O + (size_t)tq * D_ + h * 128 + 4 * g;
#pragma unroll
        for (int dt = 0; dt < 8; ++dt) { uint2 o; o.x = pack2bf(Oa[dt][0] * inv, Oa[dt][1] * inv); o.y = pack2bf(Oa[dt][2] * inv, Oa[dt][3] * inv); *(uint2*)(op + dt * 16) = o; }
    }
}
constexpr int EVL_SPLIT = 3;
__global__ void __launch_bounds__(512, 2) k_mega(Params p) {
    extern __shared__ __attribute__((aligned(16))) unsigned char shm[];
    if (threadIdx.x == 0) *(uint4*)(shm + LDS_BAR_OFF) = make_uint4(0u, 0u, 0u, 0u);
    __syncthreads();
    XcdBarrier bar = xcd_barrier_post(p.bar, (volatile LAS unsigned*)(shm + LDS_BAR_OFF));
    PG8_LAS unsigned char* glds = (PG8_LAS unsigned char*)shm;

    phase_cvt_x(p);
    phase_cvt_w(p, shm, (int)blockIdx.x, (int)gridDim.x, 0, 1 << 30);
    phase_cvt_gatew(p.ev_w_r, p.ev_w_i, p.Wt, (int)blockIdx.x, (int)gridDim.x);
    phase_cvt_w8(p, shm);
    phase_quant_tables_i8(p.pk_u, p.pk_v, p.Uq, p.Vq, p.SU, p.SV, (int)blockIdx.x, (int)gridDim.x, 0, 131072);
    xcd_barrier(bar);

    for (int l = 0; l < 4; ++l) {
        const int i = l >> 1;
        const bf16_t* wres;
        if ((l & 1) == 0) {
            { pg8::Gemm g{(const bf16_t*)p.xq, (const bf16_t*)(p.Win8 + (size_t)i * 5120 * 512), T_, 4096, 1024, 0}; pg8::EpiI8Bf16 e{(bf16_t*)p.Z, p.SXB, p.SWin + (size_t)i * 5120, 5120};
              pg8::StaticOrder S; S.init(g.M, g.N, (int)gridDim.x, (int)blockIdx.x);
              pg8::gemm_phase<pg8::EpiI8Bf16, pg8::StaticOrder, false, true>(glds, g, S, e, nullptr); }
            xcd_barrier(bar);
            { const int G = (int)gridDim.x, b = (int)blockIdx.x;
              if (G == 256) {
                  if (b < 128) {
                      { pg8::Gemm g{(const bf16_t*)p.xq, (const bf16_t*)(p.Win8 + ((size_t)i * 5120 + 4096) * 512), T_, 1024, 1024, 0}; pg8::EpiI8Bf16 e{(bf16_t*)p.Z + 4096, p.SXB, p.SWin + (size_t)i * 5120 + 4096, 5120};
                          pg8::StaticOrder S; S.init(g.M, g.N, 128, b);
                          pg8::gemm_phase<pg8::EpiI8Bf16, pg8::StaticOrder, false, true>(glds, g, S, e, nullptr); } }
                  const int u0 = b < 128 ? b : EVL_SPLIT * 128 + (b - 128), u1 = b < 128 ? EVL_SPLIT * 128 : 2048;
                  phase_even_local((const bf16_t*)p.Z, p.ev_conv_b_w + (size_t)i * 2 * 4 * 1024, p.ev_conv_b_b + (size_t)i * 2 * 1024, p.Wt + (size_t)i * 16 * 2 * 128 * 128,
                                   p.ev_b_r + (size_t)i * 2048, p.ev_b_i + (size_t)i * 2048, p.ev_lam + (size_t)i * 2048, (bf16_t*)p.AA, (bf16_t*)p.UU, p.XC, shm, u0, u1, 128);
              } else {
                  { pg8::Gemm g{(const bf16_t*)p.xq, (const bf16_t*)(p.Win8 + ((size_t)i * 5120 + 4096) * 512), T_, 1024, 1024, 0}; pg8::EpiI8Bf16 e{(bf16_t*)p.Z + 4096, p.SXB, p.SWin + (size_t)i * 5120 + 4096, 5120};
                    pg8::StaticOrder S; S.init(g.M, g.N, G, b);
                    pg8::gemm_phase<pg8::EpiI8Bf16, pg8::StaticOrder, false, true>(glds, g, S, e, nullptr); }
                  phase_even_local((const bf16_t*)p.Z, p.ev_conv_b_w + (size_t)i * 2 * 4 * 1024, p.ev_conv_b_b + (size_t)i * 2 * 1024, p.Wt + (size_t)i * 16 * 2 * 128 * 128,
                                   p.ev_b_r + (size_t)i * 2048, p.ev_b_i + (size_t)i * 2048, p.ev_lam + (size_t)i * 2048, (bf16_t*)p.AA, (bf16_t*)p.UU, p.XC, shm, b, 2048, G);
              } }
            xcd_barrier(bar);
            phase_even_carry(p.XC, p.XC + 524288);
            xcd_barrier(bar);
            phase_even_mix((const bf16_t*)p.Z, p.ev_conv_a + (size_t)i * 3 * 1024, (const bf16_t*)p.AA, (const bf16_t*)p.UU, p.XC + 524288, p.Yb);
            wres = p.WoutT + (size_t)i * 2048 * 2048;
        } else {
            { pg8::Gemm g{(const bf16_t*)p.xq, (const bf16_t*)(p.Wqkv8 + (size_t)i * 6144 * 512), T_, 4096, 1024, 0}; pg8::EpiI8Bf16 e{(bf16_t*)p.Z, p.SXB, p.SWqkv + (size_t)i * 6144, 4096};
              pg8::StaticOrder S; S.init(g.M, g.N, (int)gridDim.x, (int)blockIdx.x);
              pg8::gemm_phase<pg8::EpiI8Bf16, pg8::StaticOrder, false, true>(glds, g, S, e, nullptr); }
            { pg8::Gemm g{(const bf16_t*)(p.Wqkv8 + ((size_t)i * 6144 + 4096) * 512), (const bf16_t*)p.xq, 2048, T_, 1024, 0}; pg8::EpiI8Bf16 e{(bf16_t*)p.Z + (size_t)T_ * 4096, p.SWqkv + (size_t)i * 6144 + 4096, p.SXB, (size_t)T_};
              pg8::StaticOrder S; S.init(g.M, g.N, (int)gridDim.x, (int)blockIdx.x);
              pg8::gemm_phase<pg8::EpiI8Bf16, pg8::StaticOrder, false, true>(glds, g, S, e, nullptr); }
            xcd_barrier(bar, At5Stage{p.od_rel_bias + (size_t)i * 16 * 15 * 31, shm});
            phase_attn5((const bf16_t*)p.Z, (const bf16_t*)p.Z + (size_t)T_ * 4096, p.od_rel_bias + (size_t)i * 16 * 15 * 31, p.Yb, shm);
            wres = p.WoT + (size_t)i * 2048 * 2048;
        }
        xcd_barrier(bar);
        { pg8::Gemm g{p.Yb, wres, T_, 2048, 2048, 0}; pg8::EpiResB16 e{(bf16_t*)p.pre, p.xb, 2048, ALPHA_};
          pg8::StaticOrder S; S.init(g.M, g.N, (int)gridDim.x, (int)blockIdx.x);
          pg8::gemm_phase<pg8::EpiResB16, pg8::StaticOrder, false>(glds, g, S, e, nullptr); }
        xcd_barrier(bar);
        phase_lnq<false>((const bf16_t*)p.pre, (const bf16_t*)nullptr, p.ln1_g + (size_t)l * D_, p.ln1_b + (size_t)l * D_, (float*)nullptr, p.x1b, p.x1q, p.SX);
        xcd_barrier(bar);
        { pg8::Gemm g{(const bf16_t*)p.x1q, (const bf16_t*)(p.Wq8 + (size_t)l * 2048 * 512), T_, 2048, 1024, 0}; pg8::EpiI8Bf16 e{(bf16_t*)p.Z, p.SX, p.SW + (size_t)l * 2048, 2048};
          pg8::StaticOrder S; S.init(g.M, g.N, (int)gridDim.x, (int)blockIdx.x);
          pg8::gemm_phase<pg8::EpiI8Bf16, pg8::StaticOrder, false, true>(glds, g, S, e, nullptr); }
        xcd_barrier(bar, TopkStage{p.pk_sub_keys + (size_t)l * 2 * 128 * 128, shm});
        phase_topk((const bf16_t*)p.Z, p.pk_sub_keys + (size_t)l * 2 * 128 * 128, (unsigned short*)p.Eb, p.Gb, shm, p.SU + (size_t)l * 16384, p.SV + (size_t)l * 16384, p.SUE);
        xcd_barrier(bar);
        phase_gather_u4(p.x1q, p.Uq + (size_t)l * 16384 * 256, (const unsigned short*)p.Eb, (int*)p.XC, shm);
        xcd_barrier(bar);
        phase_peer_fin(p.Gb, p.SUE, (const int*)p.XC, p.SX, p.WQ, p.WSC, (unsigned short*)p.Eb);
        xcd_barrier(bar);
        phase_gather_v8k((bf16_t*)p.pre, p.Vq + (size_t)l * 16384 * 512, (const unsigned short*)p.Eb, p.WQ, p.WSC, shm);
        xcd_barrier(bar);
        phase_lnq<true>(p.x1b, (const bf16_t*)p.pre, p.ln2_g + (size_t)l * D_, p.ln2_b + (size_t)l * D_, (l == 3) ? p.out : (float*)nullptr, (l == 3) ? (bf16_t*)nullptr : p.xb, (l == 3) ? (unsigned*)nullptr : p.xq, (l == 3) ? (float*)nullptr : p.SXB);
        if (l < 3) xcd_barrier(bar);
    }
}

struct WsAlloc { char* base; size_t off; void* get(size_t bytes) { void* q = base + off; off += (bytes + 255) & ~(size_t)255; return q; } };

extern "C" void kernel_launch(void* const* d_in, const int* in_sizes, int n_in, void* d_out, int out_size, void* d_ws, size_t ws_size, hipStream_t stream) {
    Params p; memset(&p, 0, sizeof(p));
    p.x = (const float*)d_in[0]; p.ev_w_in = (const float*)d_in[1]; p.ev_conv_a = (const float*)d_in[2]; p.ev_conv_b_w = (const float*)d_in[3]; p.ev_conv_b_b = (const float*)d_in[4];
    p.ev_w_r = (const float*)d_in[5]; p.ev_b_r = (const float*)d_in[6]; p.ev_w_i = (const float*)d_in[7]; p.ev_b_i = (const float*)d_in[8]; p.ev_lam = (const float*)d_in[9];
    p.ev_w_out = (const float*)d_in[10]; p.od_w_qkv = (const float*)d_in[11]; p.od_rel_bias = (const float*)d_in[12]; p.od_w_o = (const float*)d_in[13]; p.pk_w_q = (const float*)d_in[14];
    p.pk_sub_keys = (const float*)d_in[15]; p.pk_u = (const float*)d_in[16]; p.pk_v = (const float*)d_in[17];
    p.ln1_g = (const float*)d_in[18]; p.ln1_b = (const float*)d_in[19]; p.ln2_g = (const float*)d_in[20]; p.ln2_b = (const float*)d_in[21];
    p.out = (float*)d_out;
    WsAlloc W{(char*)d_ws, 0};
    const size_t TD = (size_t)T_ * D_;
    p.bar = (unsigned*)W.get(XCD_BAR_WORDS * sizeof(unsigned));
    p.xb  = (bf16_t*)W.get(TD * 2); p.x1f = (float*)W.get(TD * 4); p.x1b = (bf16_t*)W.get(TD * 2); p.x2f = (float*)W.get(TD * 4); p.pre = (float*)W.get(TD * 4);
    p.Z   = (float*)W.get((size_t)T_ * 6144 * 4); p.Yb = (bf16_t*)W.get(TD * 2);
    p.WinT = (bf16_t*)W.get((size_t)2 * 5120 * 2048 * 2); p.WoutT = (bf16_t*)W.get((size_t)2 * 2048 * 2048 * 2); p.WqkvT = (bf16_t*)W.get((size_t)2 * 6144 * 2048 * 2);
    p.WoT = (bf16_t*)W.get((size_t)2 * 2048 * 2048 * 2); p.WqT = (bf16_t*)W.get((size_t)4 * 2048 * 2048 * 2);
    p.XC = (float*)W.get((size_t)2 * T_ * 1024 * 4); p.AA = (float*)W.get((size_t)2 * T_ * 1024 * 4); p.UU = (float*)W.get((size_t)2 * T_ * 1024 * 4);
    p.Eb = (int*)W.get((size_t)T_ * 128 * 4); p.Gb = (float*)W.get((size_t)T_ * 128 * 4);
    p.Wt = (bf16_t*)W.get((size_t)2 * 16 * 2 * 128 * 128 * 2);
    p.Uq = (unsigned*)W.get((size_t)4 * 16384 * 2048); p.Vq = (unsigned*)W.get((size_t)4 * 16384 * 2048); p.SU = (float*)W.get((size_t)4 * 16384 * 4); p.SV = (float*)W.get((size_t)4 * 16384 * 4);
    p.SUE = (float*)W.get((size_t)T_ * 128 * 4); p.WQ = (unsigned char*)W.get((size_t)T_ * 128); p.WSC = (float*)W.get((size_t)T_ * 4); p.x1q = (unsigned*)W.get((size_t)T_ * 2048); p.SX = (float*)W.get((size_t)T_ * 4);
    p.Wq8 = (unsigned*)W.get((size_t)4 * 2048 * 2048); p.SW = (float*)W.get((size_t)4 * 2048 * 4);
    p.Win8 = (unsigned*)W.get((size_t)2 * 5120 * 2048); p.SWin = (float*)W.get((size_t)2 * 5120 * 4); p.Wqkv8 = (unsigned*)W.get((size_t)2 * 6144 * 2048); p.SWqkv = (float*)W.get((size_t)2 * 6144 * 4);
    p.xq = (unsigned*)W.get((size_t)T_ * 2048); p.SXB = (float*)W.get((size_t)T_ * 4);

    if (W.off > ws_size) return;
    static int grid = 0;
    if (!grid) {
        (void)hipFuncSetAttribute((const void*)k_mega, hipFuncAttributeMaxDynamicSharedMemorySize, LDS_BYTES);
        int dev = 0, cus = 0, per_cu = 0;
        (void)hipGetDevice(&dev);
        (void)hipDeviceGetAttribute(&cus, hipDeviceAttributeMultiprocessorCount, dev);
        (void)hipOccupancyMaxActiveBlocksPerMultiprocessor(&per_cu, (const void*)k_mega, 512, LDS_BYTES);
        if (cus <= 0) cus = 256;
        grid = cus * (per_cu < 1 ? 1 : 1);
    }
    (void)hipMemsetAsync(p.bar, 0, XCD_BAR_WORDS * sizeof(unsigned), stream);
    hipLaunchKernelGGL(k_mega, dim3(grid), dim3(512), LDS_BYTES, stream, p);
}
```

```cpp
#include <hip/hip_runtime.h>
#include <stdint.h>
#include <string.h>
#include <math.h>
namespace pg8 {
#define PG8_LAS __attribute__((address_space(3)))
typedef unsigned short bf16_t;
typedef short bf16x8 __attribute__((ext_vector_type(8)));
typedef float f32x4 __attribute__((ext_vector_type(4)));
typedef unsigned u32x4 __attribute__((ext_vector_type(4)));
constexpr int BM = 256, BK = 64, HALF = 128, HTB = HALF * BK * 2  , STAGE_BYTES = 8 * HTB, NXCD = 8, WGM = 8;

__host__ __device__ __forceinline__ int lds_byte(int r, int c) { const int st = (r >> 4) * 2 + (c >> 5), rr = r & 15, cc = c & 31, ob = rr * 64 + cc * 2; return st * 1024 + (ob ^ (((ob >> 9) & 1) << 5)); }
__host__ __device__ __forceinline__ void stage_rc(int b, int& R, int& C) { const int st = b / 1024, sb = b % 1024, swz = sb ^ (((sb >> 9) & 1) << 5); R = (st >> 1) * 16 + swz / 64; C = (st & 1) * 32 + (swz % 64) / 2; }
__host__ __device__ __forceinline__ int perm32(int rho) { const int n = rho >> 4, i = rho & 15; return 8 * (i >> 2) + 4 * n + (i & 3); }

struct Unit { int pm, pn; };
struct Gemm { const bf16_t* A; const bf16_t* Bt; int M, N, K, pad_; };

struct StaticOrder {
    int nM, nN, nwg, G, c;
    __host__ __device__ void init(int M, int N, int G_, int c_) { nM = M / BM; nN = N / BM; nwg = nM * nN; G = G_; c = c_; }
    __host__ __device__ bool next(int i, Unit& u) const {
        const long L = (long)i * G + c; if (L >= nwg) return false;
        int wgid = (int)L; { const int q = nwg / NXCD, r = nwg % NXCD, xcd = wgid % NXCD, off = wgid / NXCD; wgid = (xcd < r ? xcd * (q + 1) : r * (q + 1) + (xcd - r) * q) + off; }
        const int nig = WGM * nN, gid = wgid / nig, fm = gid * WGM, gsz = (nM - fm) < WGM ? (nM - fm) : WGM;
        u.pm = fm + ((wgid % nig) % gsz); u.pn = (wgid % nig) / gsz; return true;
    }
    __device__ __forceinline__ void a_ready(const Unit&) const {}
    __device__ __forceinline__ void done(const Unit&) const {}
};
struct CountedOrder : StaticOrder {
    const unsigned* ready; unsigned need; unsigned* tmo;
    __device__ __forceinline__ void a_ready(const Unit& u) const {
        if (threadIdx.x < 64) {
            const unsigned long long t0 = __builtin_amdgcn_s_memrealtime(); unsigned polls = 0;
            while ((unsigned)__builtin_amdgcn_readfirstlane(__hip_atomic_load(ready + 64 * u.pm, __ATOMIC_RELAXED, __HIP_MEMORY_SCOPE_AGENT)) < need) {
                if ((++polls & 255u) == 0u && __builtin_amdgcn_readfirstlane(__hip_atomic_load(tmo, __ATOMIC_RELAXED, __HIP_MEMORY_SCOPE_AGENT)) != 0u) break;
                if (__builtin_amdgcn_s_memrealtime() - t0 > 2000000ull) {
                    if (threadIdx.x == 0) { unsigned expect = 0u; __hip_atomic_compare_exchange_strong(tmo + 1, &expect, 0x600u | (unsigned)(u.pm & 0xff), __ATOMIC_RELAXED, __ATOMIC_RELAXED, __HIP_MEMORY_SCOPE_AGENT); __hip_atomic_store(tmo, 1u, __ATOMIC_RELAXED, __HIP_MEMORY_SCOPE_AGENT); }
                    break; }
                __builtin_amdgcn_s_sleep(2); }
            __builtin_amdgcn_fence(__ATOMIC_ACQUIRE, "agent");
            asm volatile("s_waitcnt vmcnt(0)" ::: "memory");
        }
#if !defined(BROKEN_HOOK_NO_BARRIER)
        asm volatile("" ::: "memory"); __builtin_amdgcn_s_barrier(); asm volatile("" ::: "memory");
#endif
    }
};

__device__ __forceinline__ unsigned cvt_pk_bf16(float lo, float hi) { unsigned r; asm volatile("v_cvt_pk_bf16_f32 %0, %1, %2" : "=v"(r) : "v"(lo), "v"(hi)); return r; }
typedef float f32x2 __attribute__((ext_vector_type(2)));
__device__ __forceinline__ f32x2 gelu_pk(f32x2 v) {
    const f32x2 av = __builtin_elementwise_abs(v), d = av * 0.2316418882f + 1.0f;
    f32x2 t; t.x = __builtin_amdgcn_rcpf(d.x); t.y = __builtin_amdgcn_rcpf(d.y);
    f32x2 q = t * 0.5307027145f + (-0.7265760135f); q = q * t + 0.7107068705f; q = q * t + (-0.142248368f); q = q * t + 0.127414796f; q = q * t;
    const f32x2 s = (v * v) * (-0.72134752044f);
    f32x2 e; e.x = __builtin_amdgcn_exp2f(s.x); e.y = __builtin_amdgcn_exp2f(s.y);
    const f32x2 m = v * (q * e), r = v - m;
    f32x2 o; o.x = v.x < 0.f ? m.x : r.x; o.y = v.y < 0.f ? m.y : r.y; return o;
}

struct EpiF32 {
    static constexpr bool PERM = false, AFTER_DRAIN = false;
    float* C; const float* bias; int ldc; int pad_;
    __device__ __forceinline__ void operator()(const f32x4 (&acc)[2][2][4][2], const Unit& u, int wr, int wc, int fr, int fq) const {
        const int row0 = u.pm * BM + wr * 64 + fr, col0 = u.pn * BM + wc * 32 + 4 * fq;
        f32x4 bv[2][2];
#pragma unroll
        for (int bj = 0; bj < 2; ++bj)
#pragma unroll
            for (int n = 0; n < 2; ++n) bv[bj][n] = bias ? *(const f32x4*)(bias + col0 + bj * HALF + n * 16) : (f32x4){0.f, 0.f, 0.f, 0.f};
#pragma unroll
        for (int ai = 0; ai < 2; ++ai)
#pragma unroll
            for (int m = 0; m < 4; ++m) { float* rowp = C + (size_t)(row0 + ai * HALF + m * 16) * ldc + col0;
#pragma unroll
                for (int bj = 0; bj < 2; ++bj)
#pragma unroll
                    for (int n = 0; n < 2; ++n) *(f32x4*)(rowp + bj * HALF + n * 16) = acc[ai][bj][m][n] + bv[bj][n]; }
    }
};
template <int ACT  > struct EpiBf16 {
    static constexpr bool PERM = true, AFTER_DRAIN = false;
    bf16_t* O; const float* bias; size_t split_stride; int ldc; int split_cols;
    __device__ __forceinline__ void operator()(const f32x4 (&acc)[2][2][4][2], const Unit& u, int wr, int wc, int fr, int fq) const {
        const int row0 = u.pm * BM + wr * 64 + fr; int colt = u.pn * BM; bf16_t* base = O;
        if (split_cols) { const int t = colt / split_cols; base += (size_t)t * split_stride; colt -= t * split_cols; }
        const int col0 = colt + wc * 32 + 8 * fq, bcol0 = u.pn * BM + wc * 32 + 8 * fq;
        f32x4 bv[2][2];
#pragma unroll
        for (int bj = 0; bj < 2; ++bj)
#pragma unroll
            for (int n = 0; n < 2; ++n) bv[bj][n] = bias ? *(const f32x4*)(bias + bcol0 + bj * HALF + 4 * n) : (f32x4){0.f, 0.f, 0.f, 0.f};
#pragma unroll
        for (int ai = 0; ai < 2; ++ai)
#pragma unroll
            for (int m = 0; m < 4; ++m) { bf16_t* rowp = base + (size_t)(row0 + ai * HALF + m * 16) * ldc + col0;
#pragma unroll
                for (int bj = 0; bj < 2; ++bj) { f32x4 v0 = acc[ai][bj][m][0] + bv[bj][0], v1 = acc[ai][bj][m][1] + bv[bj][1];
                    if (ACT == 1) { f32x2 a = gelu_pk((f32x2){v0[0], v0[1]}), b = gelu_pk((f32x2){v0[2], v0[3]}), c = gelu_pk((f32x2){v1[0], v1[1]}), d = gelu_pk((f32x2){v1[2], v1[3]});
                        v0 = (f32x4){a.x, a.y, b.x, b.y}; v1 = (f32x4){c.x, c.y, d.x, d.y}; }
                    if (ACT == 2) {
#pragma unroll
                        for (int j = 0; j < 4; ++j) { v0[j] = 0.5f * v0[j] * (1.0f + erff(v0[j] * 0.70710678f)); v1[j] = 0.5f * v1[j] * (1.0f + erff(v1[j] * 0.70710678f)); } }
                    u32x4 w; w.x = cvt_pk_bf16(v0[0], v0[1]); w.y = cvt_pk_bf16(v0[2], v0[3]); w.z = cvt_pk_bf16(v1[0], v1[1]); w.w = cvt_pk_bf16(v1[2], v1[3]);
                    *(u32x4*)(rowp + bj * HALF) = w; } }
    }
};
struct EpiResB16 {
    static constexpr bool PERM = true, AFTER_DRAIN = false;
    bf16_t* O; const bf16_t* X; int ldc; float alpha;
    __device__ __forceinline__ void operator()(const f32x4 (&acc)[2][2][4][2], const Unit& u, int wr, int wc, int fr, int fq) const {
        const int row0 = u.pm * BM + wr * 64 + fr, col0 = u.pn * BM + wc * 32 + 8 * fq;
#pragma unroll
        for (int ai = 0; ai < 2; ++ai)
#pragma unroll
            for (int m = 0; m < 4; ++m) { const size_t ro = (size_t)(row0 + ai * HALF + m * 16) * ldc + col0;
#pragma unroll
                for (int bj = 0; bj < 2; ++bj) { const u32x4 xb = *(const u32x4*)(X + ro + bj * HALF);
                    const f32x4 v0 = acc[ai][bj][m][0], v1 = acc[ai][bj][m][1];
                    u32x4 w;
                    w.x = cvt_pk_bf16(v0[0] + alpha * __uint_as_float(xb.x << 16), v0[1] + alpha * __uint_as_float(xb.x & 0xffff0000u));
                    w.y = cvt_pk_bf16(v0[2] + alpha * __uint_as_float(xb.y << 16), v0[3] + alpha * __uint_as_float(xb.y & 0xffff0000u));
                    w.z = cvt_pk_bf16(v1[0] + alpha * __uint_as_float(xb.z << 16), v1[1] + alpha * __uint_as_float(xb.z & 0xffff0000u));
                    w.w = cvt_pk_bf16(v1[2] + alpha * __uint_as_float(xb.w << 16), v1[3] + alpha * __uint_as_float(xb.w & 0xffff0000u));
                    *(u32x4*)(O + ro + bj * HALF) = w; } }
    }
};

struct EpiI8Bf16 {
    static constexpr bool PERM = true, AFTER_DRAIN = false;
    bf16_t* O; const float* rs; const float* cs; size_t ldc;
    __device__ __forceinline__ void operator()(const f32x4 (&acc)[2][2][4][2], const Unit& u, int wr, int wc, int fr, int fq) const {
        const int row0 = u.pm * BM + wr * 64 + fr, col0 = u.pn * BM + wc * 32 + 8 * fq;
        f32x4 cv[2][2];
#pragma unroll
        for (int bj = 0; bj < 2; ++bj)
#pragma unroll
            for (int n = 0; n < 2; ++n) cv[bj][n] = *(const f32x4*)(cs + col0 + bj * HALF + 4 * n);
#pragma unroll
        for (int ai = 0; ai < 2; ++ai)
#pragma unroll
            for (int m = 0; m < 4; ++m) { const int row = row0 + ai * HALF + m * 16; const float r = rs[row]; bf16_t* rowp = O + (size_t)row * ldc + col0;
#pragma unroll
                for (int bj = 0; bj < 2; ++bj) { f32x4 v0, v1;
#pragma unroll
                    for (int j = 0; j < 4; ++j) { v0[j] = (float)__float_as_int(acc[ai][bj][m][0][j]) * (r * cv[bj][0][j]); v1[j] = (float)__float_as_int(acc[ai][bj][m][1][j]) * (r * cv[bj][1][j]); }
                    u32x4 w; w.x = cvt_pk_bf16(v0[0], v0[1]); w.y = cvt_pk_bf16(v0[2], v0[3]); w.z = cvt_pk_bf16(v1[0], v1[1]); w.w = cvt_pk_bf16(v1[2], v1[3]);
                    *(u32x4*)(rowp + bj * HALF) = w; } }
    }
};

struct EpiI8ResB16 {
    static constexpr bool PERM = true, AFTER_DRAIN = false;
    bf16_t* O; const bf16_t* X; const float* rs; const float* cs; size_t ldc; float alpha; int pad_;
    __device__ __forceinline__ void operator()(const f32x4 (&acc)[2][2][4][2], const Unit& u, int wr, int wc, int fr, int fq) const {
        const int row0 = u.pm * BM + wr * 64 + fr, col0 = u.pn * BM + wc * 32 + 8 * fq;
        f32x4 cv[2][2];
#pragma unroll
        for (int bj = 0; bj < 2; ++bj)
#pragma unroll
            for (int n = 0; n < 2; ++n) cv[bj][n] = *(const f32x4*)(cs + col0 + bj * HALF + 4 * n);
#pragma unroll
        for (int ai = 0; ai < 2; ++ai)
#pragma unroll
            for (int m = 0; m < 4; ++m) { const int row = row0 + ai * HALF + m * 16; const float r = rs[row]; const size_t ro = (size_t)row * ldc + col0;
#pragma unroll
                for (int bj = 0; bj < 2; ++bj) { const u32x4 xb = *(const u32x4*)(X + ro + bj * HALF);
                    f32x4 v0, v1;
#pragma unroll
                    for (int j = 0; j < 4; ++j) { v0[j] = (float)__float_as_int(acc[ai][bj][m][0][j]) * (r * cv[bj][0][j]); v1[j] = (float)__float_as_int(acc[ai][bj][m][1][j]) * (r * cv[bj][1][j]); }
                    u32x4 w;
                    w.x = cvt_pk_bf16(v0[0] + alpha * __uint_as_float(xb.x << 16), v0[1] + alpha * __uint_as_float(xb.x & 0xffff0000u));
                    w.y = cvt_pk_bf16(v0[2] + alpha * __uint_as_float(xb.y << 16), v0[3] + alpha * __uint_as_float(xb.y & 0xffff0000u));
                    w.z = cvt_pk_bf16(v1[0] + alpha * __uint_as_float(xb.z << 16), v1[1] + alpha * __uint_as_float(xb.z & 0xffff0000u));
                    w.w = cvt_pk_bf16(v1[2] + alpha * __uint_as_float(xb.w << 16), v1[3] + alpha * __uint_as_float(xb.w & 0xffff0000u));
                    *(u32x4*)(O + ro + bj * HALF) = w; } }
    }
};

template <bool I8> __device__ __forceinline__ f32x4 mma16(const bf16x8 a, const bf16x8 b, const f32x4 c) {
    if constexpr (I8) { typedef int i32x4_ __attribute__((ext_vector_type(4)));
        return __builtin_bit_cast(f32x4, __builtin_amdgcn_mfma_i32_16x16x64_i8(__builtin_bit_cast(i32x4_, a), __builtin_bit_cast(i32x4_, b), __builtin_bit_cast(i32x4_, c), 0, 0, 0)); }
    else return __builtin_amdgcn_mfma_f32_16x16x32_bf16(a, b, c, 0, 0, 0);
}
template <class Epi, class Sched, bool STAMP = false, bool I8 = false>
__device__ __forceinline__ void gemm_phase(PG8_LAS unsigned char* lds, const Gemm g, const Sched& S, const Epi& E, unsigned long long* stamps) {
    int tid_ = threadIdx.x; asm volatile("" : "+v"(tid_));
    const int tid = tid_, wid = __builtin_amdgcn_readfirstlane(tid >> 6), lane = tid & 63, wr = wid >> 2, wc = wid & 3, fr = lane & 15, fq = lane >> 4;
    const int K = g.K, nt = K / BK;
    int ts_lo = 0, ts_hi = 0, nts = 0; const unsigned long long rt_entry = STAMP ? (unsigned long long)wall_clock64() : 0ull;
#define PG8_STAMP() do { if (STAMP && wid == 0 && nts < 64) { const unsigned long long _c = (unsigned long long)clock64(); \
        ts_lo = (lane == nts) ? (int)(unsigned)_c : ts_lo; ts_hi = (lane == nts) ? (int)(unsigned)(_c >> 32) : ts_hi; ++nts; } } while (0)
    PG8_STAMP();
    unsigned voffA[2], voffB[2];
#pragma unroll
    for (int i = 0; i < 2; ++i) { int R, C; stage_rc(tid * 16 + i * 8192, R, C); const int Rb = Epi::PERM ? ((R & ~31) + perm32(R & 31)) : R;
        voffA[i] = (unsigned)(R * K + C) * 2u; voffB[i] = (unsigned)(Rb * K + C) * 2u; }
    const size_t kstep = (size_t)(BK * 2);
    const size_t hstep = (size_t)HALF * K * 2;
    const size_t tstep = 2 * hstep;
    const unsigned ldsw = (unsigned)wid * 1024u;
    const int aoff = lds_byte(wr * 64 + fr, fq * 8), boff = lds_byte(wc * 32 + fr, fq * 8);
#define PG8_SA(b, h) (((b) * 2 + (h)) * HTB)
#define PG8_SB(b, h) ((4 + (b) * 2 + (h)) * HTB)
#define PG8_STAGE(bufoff, gbase, voff) do { _Pragma("unroll") for (int _i = 0; _i < 2; ++_i) \
        __builtin_amdgcn_global_load_lds((const unsigned*)((const char*)(gbase) + (voff)[_i]), (PG8_LAS unsigned*)(lds + (bufoff) + ldsw + _i * 8192), 16, 0, 0); } while (0)
#define PG8_LDA(dst, b, h) do { _Pragma("unroll") for (int m = 0; m < 4; ++m) _Pragma("unroll") for (int k = 0; k < 2; ++k) dst[m][k] = *(const PG8_LAS bf16x8*)(lds + PG8_SA(b, h) + aoff + m * 2048 + k * 1024); } while (0)
#define PG8_LDB(dst, b, h) do { _Pragma("unroll") for (int n = 0; n < 2; ++n) _Pragma("unroll") for (int k = 0; k < 2; ++k) dst[n][k] = *(const PG8_LAS bf16x8*)(lds + PG8_SB(b, h) + boff + n * 2048 + k * 1024); } while (0)
#define PG8_MMA(ai, bj, At, Bt) do { __builtin_amdgcn_s_setprio(1); _Pragma("unroll") for (int m = 0; m < 4; ++m) _Pragma("unroll") for (int n = 0; n < 2; ++n) _Pragma("unroll") for (int k = 0; k < 2; ++k) \
        acc[ai][bj][m][n] = mma16<I8>(Bt[n][k], At[m][k], acc[ai][bj][m][n]); __builtin_amdgcn_s_setprio(0); } while (0)
#define PG8_WAIT_V(n) asm volatile("s_waitcnt vmcnt(" #n ")" ::: "memory")
#define PG8_WAIT_L(n) asm volatile("s_waitcnt lgkmcnt(" #n ")" ::: "memory")
#define PG8_BAR __builtin_amdgcn_s_barrier()
#define PG8_SCHED __builtin_amdgcn_sched_barrier(0)
    Unit cur, nxt; int ui = 0;
    if (!S.next(0, cur)) return;
    f32x4 acc[2][2][4][2];
#pragma unroll
    for (int a = 0; a < 2; ++a)
#pragma unroll
        for (int b = 0; b < 2; ++b)
#pragma unroll
            for (int m = 0; m < 4; ++m)
#pragma unroll
                for (int n = 0; n < 2; ++n) acc[a][b][m][n] = (f32x4){0.f, 0.f, 0.f, 0.f};
    bf16x8 At[4][2], B0[2][2], B1[2][2];
    const char* cA = (const char*)g.A + (size_t)cur.pm * tstep; const char* cB = (const char*)g.Bt + (size_t)cur.pn * tstep;
    S.a_ready(cur);
    PG8_STAGE(PG8_SB(0, 0), cB, voffB); PG8_STAGE(PG8_SA(0, 0), cA, voffA); PG8_STAGE(PG8_SB(0, 1), cB + hstep, voffB); PG8_STAGE(PG8_SA(0, 1), cA + hstep, voffA);
    if (wr == 1) PG8_BAR;
    PG8_WAIT_V(4); PG8_BAR;
    PG8_STAGE(PG8_SB(1, 0), cB + kstep, voffB); PG8_STAGE(PG8_SA(1, 0), cA + kstep, voffA); PG8_STAGE(PG8_SB(1, 1), cB + hstep + kstep, voffB);
    PG8_WAIT_V(6); PG8_BAR;
    PG8_STAMP();
    for (;;) {
        const bool has_next = S.next(ui + 1, nxt);
        const char* nA = has_next ? (const char*)g.A + (size_t)nxt.pm * tstep : cA; const char* nB = has_next ? (const char*)g.Bt + (size_t)nxt.pn * tstep : cB;
        for (int t = 0; t < nt; t += 2) {
            const bool last = (t == nt - 2);
            const char* a1 = cA + (size_t)(t + 1) * kstep;
            const char* a2 = last ? nA : cA + (size_t)(t + 2) * kstep; const char* b2 = last ? nB : cB + (size_t)(t + 2) * kstep;
            const char* a3 = a2 + kstep; const char* b3 = b2 + kstep;
            if (last && has_next) S.a_ready(nxt);
            PG8_LDB(B0, 0, 0); PG8_SCHED; PG8_LDA(At, 0, 0); PG8_STAGE(PG8_SA(1, 1), a1 + hstep, voffA);
            PG8_WAIT_L(8); PG8_BAR; PG8_WAIT_L(0); PG8_MMA(0, 0, At, B0); PG8_BAR; PG8_SCHED;
            PG8_LDB(B1, 0, 1); PG8_STAGE(PG8_SB(0, 0), b2, voffB);
            PG8_BAR; PG8_WAIT_L(0); PG8_MMA(0, 1, At, B1); PG8_BAR;
            PG8_LDA(At, 0, 1); PG8_STAGE(PG8_SA(0, 0), a2, voffA);
            PG8_BAR; PG8_WAIT_L(0); PG8_MMA(1, 0, At, B0); PG8_BAR; PG8_SCHED;
            PG8_STAGE(PG8_SB(0, 1), b2 + hstep, voffB);
            PG8_WAIT_V(6); PG8_BAR; PG8_MMA(1, 1, At, B1); PG8_BAR;
            PG8_LDB(B0, 1, 0); PG8_SCHED; PG8_LDA(At, 1, 0); PG8_STAGE(PG8_SA(0, 1), a2 + hstep, voffA);
            PG8_WAIT_L(8); PG8_BAR; PG8_WAIT_L(0); PG8_MMA(0, 0, At, B0); PG8_BAR; PG8_SCHED;
            PG8_LDB(B1, 1, 1); PG8_STAGE(PG8_SB(1, 0), b3, voffB);
            PG8_BAR; PG8_WAIT_L(0); PG8_MMA(0, 1, At, B1); PG8_BAR;
            PG8_LDA(At, 1, 1); PG8_STAGE(PG8_SA(1, 0), a3, voffA);
            PG8_BAR; PG8_WAIT_L(0); PG8_MMA(1, 0, At, B0); PG8_BAR; PG8_SCHED;
            PG8_STAGE(PG8_SB(1, 1), b3 + hstep, voffB);
            PG8_WAIT_V(6); PG8_BAR; PG8_MMA(1, 1, At, B1); PG8_BAR;
        }
        PG8_STAMP();
        if constexpr (!Epi::AFTER_DRAIN) { E(acc, cur, wr, wc, fr, fq); S.done(cur); }
        PG8_STAMP();
        if (!has_next) break;
#pragma unroll
        for (int a = 0; a < 2; ++a)
#pragma unroll
            for (int b = 0; b < 2; ++b)
#pragma unroll
                for (int m = 0; m < 4; ++m)
#pragma unroll
                    for (int n = 0; n < 2; ++n) acc[a][b][m][n] = (f32x4){0.f, 0.f, 0.f, 0.f};
        cur = nxt; cA = nA; cB = nB; ++ui;
    }
    PG8_WAIT_V(0);
    if (wr == 0) PG8_BAR;
    PG8_BAR;
    if constexpr (Epi::AFTER_DRAIN) { E.fused(acc, cur, wr, wc, fr, fq, lds, wid, lane); S.done(cur); }
    PG8_STAMP();
    if (STAMP && wid == 0) { stamps[lane] = lane < nts ? (((unsigned long long)(unsigned)ts_hi << 32) | (unsigned)ts_lo) : 0ull;
        if (lane == 62) stamps[62] = rt_entry; if (lane == 63) stamps[63] = (unsigned long long)wall_clock64(); }
#undef PG8_STAMP
#undef PG8_SA
#undef PG8_SB
#undef PG8_STAGE
#undef PG8_LDA
#undef PG8_LDB
#undef PG8_MMA
#undef PG8_WAIT_V
#undef PG8_WAIT_L
#undef PG8_BAR
#undef PG8_SCHED
}
}
#define XB_TMO      128
#define XB_XCNT(j)  (256  + 64 * (j))
#define XB_XSUB(j)  (1280 + 64 * (j))
#define XB_XGEN(j)  (2304 + 64 * (j))
#define XB_TOP      3328
#define XB_TOPGEN   3392
#define XCD_BAR_WORDS 3456
#define XB_SPIN_CAP (1u << 18)
#define LAS __attribute__((address_space(3)))

__device__ __forceinline__ unsigned xb_ld(unsigned* p)              { return __hip_atomic_load(p, __ATOMIC_RELAXED, __HIP_MEMORY_SCOPE_AGENT); }
__device__ __forceinline__ unsigned xb_add(unsigned* p, unsigned v) { return __hip_atomic_fetch_add(p, v, __ATOMIC_RELAXED, __HIP_MEMORY_SCOPE_AGENT); }
__device__ __forceinline__ unsigned xb_xcc_id() { return (unsigned)__builtin_amdgcn_s_getreg((3 << 11) | 20) & 0xFu; }
#define XB_SPIN(cond, bar) do { unsigned _sp = 0; while (cond) { \
    if ((++_sp & 255u) == 0u) { if (xb_ld(&(bar)[XB_TMO])) break; if (_sp > XB_SPIN_CAP) { atomicAdd(&(bar)[XB_TMO], 1u); break; } } } } while (0)

struct XcdBarrier {
    volatile LAS unsigned* st;
};

__device__ __forceinline__ XcdBarrier xcd_barrier_post(unsigned* bar, volatile LAS unsigned* st) {
    XcdBarrier b; b.st = st;
    if (threadIdx.x == 0) { st[2] = (unsigned)(unsigned long long)bar; st[3] = (unsigned)((unsigned long long)bar >> 32); (void)xb_add(&bar[XB_XCNT(xb_xcc_id())], 1u); }
    return b;
}
__device__ __forceinline__ void xcd_barrier_complete(unsigned* bar, unsigned x, unsigned& nloc, unsigned& nx) {
    const unsigned G = gridDim.x * gridDim.y * gridDim.z;
    unsigned sum, cnt, mine, sp = 0u;
    for (;;) {
        sum = 0u; cnt = 0u; mine = 0u;
#pragma unroll
        for (unsigned j = 0; j < 16; ++j) { const unsigned c = xb_ld(&bar[XB_XCNT(j)]); sum += c; cnt += (c > 0u) ? 1u : 0u; mine = (j == x) ? c : mine; }
        if (sum == G) break;
        __builtin_amdgcn_s_sleep(1);
        if ((++sp & 255u) == 0u) { if (xb_ld(&bar[XB_TMO])) break; if (sp > XB_SPIN_CAP) { atomicAdd(&bar[XB_TMO], 1u); break; } }
    }
    nloc = mine > 0u ? mine : 1u; nx = cnt > 0u ? cnt : 1u;
}

struct XbNoWork { __device__ __forceinline__ void operator()(int) const {} };
template <class WORK = XbNoWork> __device__ __forceinline__ void xcd_barrier(const XcdBarrier& b, WORK work = WORK()) {
    asm volatile("s_waitcnt vmcnt(0)" ::: "memory");
    __syncthreads();
    if (threadIdx.x == 0) {
        unsigned* bar = (unsigned*)(((unsigned long long)b.st[3] << 32) | (unsigned long long)b.st[2]);
        const unsigned bx = xb_xcc_id();
        __builtin_amdgcn_s_waitcnt(0);
        unsigned nloc = b.st[0], nx = b.st[1];
        if (nloc == 0u) { xcd_barrier_complete(bar, bx, nloc, nx); b.st[0] = nloc; b.st[1] = nx; }
        const unsigned old = xb_add(&bar[XB_XSUB(bx)], 1u);
        const unsigned gen = old / nloc;
        if (old + 1u == (gen + 1u) * nloc) {
            __builtin_amdgcn_fence(__ATOMIC_RELEASE, "agent");
            asm volatile("s_waitcnt vmcnt(0)" ::: "memory");
            const unsigned og = xb_add(&bar[XB_TOP], 1u);
            const unsigned tg = og / nx;
            if (og + 1u == (tg + 1u) * nx) xb_add(&bar[XB_TOPGEN], 1u);
            else XB_SPIN(xb_ld(&bar[XB_TOPGEN]) == tg, bar);
            __builtin_amdgcn_fence(__ATOMIC_ACQUIRE, "agent");
            asm volatile("s_waitcnt vmcnt(0)" ::: "memory");
        } else {
            XB_SPIN(xb_ld(&bar[XB_TOPGEN]) == gen, bar);
            __builtin_amdgcn_fence(__ATOMIC_ACQUIRE, "agent");
            asm volatile("s_waitcnt vmcnt(0)" ::: "memory");
        }
    } else { int tw_ = threadIdx.x; asm volatile("" : "+v"(tw_)); if (tw_ >= 64) work(tw_ - 64); }
    __syncthreads();
}
constexpr int T_ = 8192, D_ = 2048, GW_ = 64, NROWS_ = 128, NZ_ = 5120;
constexpr float ALPHA_ = 1.681792830507429f;
constexpr float LN_EPS_ = 1e-5f;
constexpr int NTHR = 512;
constexpr int LDS_BYTES = 163840;
constexpr int LDS_BAR_OFF = LDS_BYTES - 16;
typedef unsigned short bf16_t;

__device__ __forceinline__ bf16_t f2bf(float f) { unsigned u = __float_as_uint(f); u += 0x7FFFu + ((u >> 16) & 1u); return (bf16_t)(u >> 16); }
__device__ __forceinline__ float bf2f(bf16_t b) { return __uint_as_float(((unsigned)b) << 16); }
__device__ __forceinline__ float gelu_exact(float v) { return 0.5f * v * (1.0f + erff(v * 0.70710678118654752f)); }
__device__ __forceinline__ float sigmoidf_(float v) { return 1.0f / (1.0f + expf(-v)); }
__device__ __forceinline__ int otid() { int t = threadIdx.x; asm volatile("" : "+v"(t)); return t; }
template <int CTRL> __device__ __forceinline__ float dpp_f(float v) { return __int_as_float(__builtin_amdgcn_update_dpp(0, __float_as_int(v), CTRL, 0xf, 0xf, true)); }
__device__ __forceinline__ float rows4_sum(float v) {
    const auto a = __builtin_amdgcn_permlane16_swap(__float_as_uint(v), __float_as_uint(v), false, false); v = __uint_as_float(a[0]) + __uint_as_float(a[1]);
    const auto b = __builtin_amdgcn_permlane32_swap(__float_as_uint(v), __float_as_uint(v), false, false); return __uint_as_float(b[0]) + __uint_as_float(b[1]); }
__device__ __forceinline__ float rows4_max(float v) {
    const auto a = __builtin_amdgcn_permlane16_swap(__float_as_uint(v), __float_as_uint(v), false, false); v = fmaxf(__uint_as_float(a[0]), __uint_as_float(a[1]));
    const auto b = __builtin_amdgcn_permlane32_swap(__float_as_uint(v), __float_as_uint(v), false, false); return fmaxf(__uint_as_float(b[0]), __uint_as_float(b[1])); }
__device__ __forceinline__ float wave_sum_f(float v) { v += dpp_f<0xB1>(v); v += dpp_f<0x4E>(v); v += dpp_f<0x141>(v); v += dpp_f<0x140>(v); return rows4_sum(v); }
__device__ __forceinline__ float wave_max_f(float v) { v = fmaxf(v, dpp_f<0xB1>(v)); v = fmaxf(v, dpp_f<0x4E>(v)); v = fmaxf(v, dpp_f<0x141>(v)); v = fmaxf(v, dpp_f<0x140>(v)); return rows4_max(v); }

struct Params {
    const float *x, *ev_w_in, *ev_conv_a, *ev_conv_b_w, *ev_conv_b_b, *ev_w_r, *ev_b_r, *ev_w_i, *ev_b_i, *ev_lam, *ev_w_out,
                *od_w_qkv, *od_rel_bias, *od_w_o, *pk_w_q, *pk_sub_keys, *pk_u, *pk_v, *ln1_g, *ln1_b, *ln2_g, *ln2_b;
    float* out;
    unsigned* bar;
    bf16_t *xb, *x1b, *Yb, *WinT, *WoutT, *WqkvT, *WoT, *WqT, *Wt;
    unsigned *Uq, *Vq, *x1q, *Wq8, *Win8, *Wqkv8, *xq, *Yq, *Wout8;
    float *SU, *SV, *SX, *SUE, *WSC, *SW, *SWin, *SWqkv, *SXB, *SY, *SWout;
    unsigned char* WQ;
    float *x1f, *x2f, *pre, *Z, *XC, *AA, *UU, *Gb;
    int* Eb;
};

__device__ __forceinline__ void phase_cvt_x(const Params& p) {
    const int tix = otid();
    const int lane = tix & 63, w = tix >> 6;
    const int rstep = (int)gridDim.x * 8;
    for (int r0 = (int)blockIdx.x * 8 + w; r0 < T_; r0 += 2 * rstep) {
        float4 v[2][8];
#pragma unroll
        for (int k = 0; k < 2; ++k) { const int t = (r0 + k * rstep < T_) ? r0 + k * rstep : r0;
#pragma unroll
            for (int i = 0; i < 8; ++i) v[k][i] = *(const float4*)(p.x + (size_t)t * D_ + i * 256 + lane * 4); }
#pragma unroll
        for (int k = 0; k < 2; ++k) { const int t = r0 + k * rstep;
            if (t < T_) { float m = 0.f;
#pragma unroll
                for (int i = 0; i < 8; ++i) { const float4 y = v[k][i]; m = fmaxf(m, fmaxf(fmaxf(fabsf(y.x), fabsf(y.y)), fmaxf(fabsf(y.z), fabsf(y.w))));
                    uint2 o; o.x = (unsigned)f2bf(y.x) | ((unsigned)f2bf(y.y) << 16); o.y = (unsigned)f2bf(y.z) | ((unsigned)f2bf(y.w) << 16);
                    *(uint2*)(p.xb + (size_t)t * D_ + i * 256 + lane * 4) = o; }
#pragma unroll
                for (int o = 32; o >= 1; o >>= 1) m = fmaxf(m, __shfl_xor(m, o));
                const float sc = m > 0.f ? 127.0f / m : 0.f;
#pragma unroll
                for (int i = 0; i < 8; ++i) { const int a = (int)rintf(v[k][i].x * sc), b = (int)rintf(v[k][i].y * sc), c = (int)rintf(v[k][i].z * sc), d = (int)rintf(v[k][i].w * sc);
                    p.xq[(size_t)t * 512 + i * 64 + lane] = (unsigned)(a & 255) | ((unsigned)(b & 255) << 8) | ((unsigned)(c & 255) << 16) | ((unsigned)(d & 255) << 24); }
                if (lane == 0) p.SXB[t] = m * (1.0f / 127.0f); } }
    }
}
__device__ __forceinline__ void phase_cvt_w(const Params& p, unsigned char* lds, int bid, int nb_, int ubeg, int uend) {
    const int tix = otid();
    float (*tile)[65] = (float (*)[65])lds;
    constexpr int NB_O = 2 * 2048 / 64;
    constexpr int NB = NB_O;
    const int tx = tix & 63, ty = tix >> 6;
    if (uend > NB * 8) uend = NB * 8;
    for (int u = ubeg + bid; u < uend; u += nb_) {
        int nb = u >> 3; const int kb = u & 7;
        const float* src; bf16_t* dst; int N, per;
        { src = p.od_w_o; dst = p.WoT; N = 2048; per = 32; }
        const int mat = nb / per, nbl = nb % per;
        src += (size_t)mat * 2048 * N; dst += (size_t)mat * 2048 * N;
        const int n0 = nbl * 64, k0 = kb * 256;
        int ns = n0;
        if (N == 5120 && n0 >= 3072) ns = (n0 < 4096) ? n0 + 1024 : n0 - 1024;
        float v[32];
#pragma unroll
        for (int i = 0; i < 32; ++i) v[i] = src[(size_t)(k0 + i * 8 + ty) * N + ns + tx];
        __syncthreads();
#pragma unroll
        for (int i = 0; i < 32; ++i) tile[i * 8 + ty][tx] = v[i];
        __syncthreads();
#pragma unroll
        for (int i = 0; i < 8; ++i) { const int n = i * 8 + ty;
#pragma unroll
            for (int j = 0; j < 2; ++j) { const int k = j * 128 + 2 * tx;
                *(unsigned*)(dst + (size_t)(n0 + n) * 2048 + k0 + k) = (unsigned)f2bf(tile[k][n]) | ((unsigned)f2bf(tile[k + 1][n]) << 16); } }
    }
}

__device__ __forceinline__ void phase_cvt_w8(const Params& p, unsigned char* lds) {
    const int tix = otid();
    const int lane = tix & 63, w = tix >> 6, tx = tix & 31, ty = tix >> 5;
    constexpr int NU_IN = 2 * 5120 / 32, NU_QKV = 2 * 6144 / 32, NU_Q = 4 * 2048 / 32, NU_OUT = 2 * 2048 / 32, ROWB = 4112;
    for (int u = blockIdx.x; u < NU_IN + NU_QKV + NU_Q + NU_OUT; u += gridDim.x) {
        int nb = u; const float* src; unsigned* dst8; float* sdst; int N, per;
        if (nb < NU_IN) { src = p.ev_w_in; dst8 = p.Win8; sdst = p.SWin; N = 5120; per = 160; }
        else if ((nb -= NU_IN) < NU_QKV) { src = p.od_w_qkv; dst8 = p.Wqkv8; sdst = p.SWqkv; N = 6144; per = 192; }
        else if ((nb -= NU_QKV) < NU_Q) { src = p.pk_w_q; dst8 = p.Wq8; sdst = p.SW; N = 2048; per = 64; }
        else { nb -= NU_Q; src = p.ev_w_out; dst8 = p.Wout8; sdst = p.SWout; N = 2048; per = 64; }
        const int mat = nb / per, n0 = (nb % per) * 32;
        src += (size_t)mat * 2048 * N;
        int ns = n0;
        if (N == 5120 && n0 >= 3072) ns = (n0 < 4096) ? n0 + 1024 : n0 - 1024;
        const size_t orow0 = (size_t)mat * N + n0;
        __syncthreads();
#pragma unroll 1
        for (int b = 0; b < 2; ++b) { float4 v0[8], v1[8];
            const int tx4 = (tix & 7) * 4, typ = tix >> 3;
#pragma unroll
            for (int i = 0; i < 8; ++i) { const int k = b * 1024 + i * 128 + typ * 2; v0[i] = *(const float4*)(src + (size_t)k * N + ns + tx4); v1[i] = *(const float4*)(src + (size_t)(k + 1) * N + ns + tx4); }
#pragma unroll
            for (int i = 0; i < 8; ++i) { const int k = b * 1024 + i * 128 + typ * 2; unsigned char* lp = lds + tx4 * ROWB + k * 2;
                *(unsigned*)(lp) = (unsigned)f2bf(v0[i].x) | ((unsigned)f2bf(v1[i].x) << 16); *(unsigned*)(lp + ROWB) = (unsigned)f2bf(v0[i].y) | ((unsigned)f2bf(v1[i].y) << 16);
                *(unsigned*)(lp + 2 * ROWB) = (unsigned)f2bf(v0[i].z) | ((unsigned)f2bf(v1[i].z) << 16); *(unsigned*)(lp + 3 * ROWB) = (unsigned)f2bf(v0[i].w) | ((unsigned)f2bf(v1[i].w) << 16); } }
        __syncthreads();
#pragma unroll 1
        for (int r = 0; r < 4; ++r) { const int n = w * 4 + r;
            const uint4* rowp = (const uint4*)(lds + n * ROWB) + lane * 4;
            float f[32]; float m = 0.f;
#pragma unroll
            for (int j = 0; j < 4; ++j) { const uint4 q = rowp[j];
                f[j * 8 + 0] = __uint_as_float(q.x << 16); f[j * 8 + 1] = __uint_as_float(q.x & 0xffff0000u); f[j * 8 + 2] = __uint_as_float(q.y << 16); f[j * 8 + 3] = __uint_as_float(q.y & 0xffff0000u);
                f[j * 8 + 4] = __uint_as_float(q.z << 16); f[j * 8 + 5] = __uint_as_float(q.z & 0xffff0000u); f[j * 8 + 6] = __uint_as_float(q.w << 16); f[j * 8 + 7] = __uint_as_float(q.w & 0xffff0000u); }
#pragma unroll
            for (int j = 0; j < 32; ++j) m = fmaxf(m, fabsf(f[j]));
            m = wave_max_f(m);
            const float sc = m > 0.f ? 127.0f / m : 0.f;
            unsigned o[8];
#pragma unroll
            for (int j = 0; j < 8; ++j) { const int a = (int)rintf(f[4 * j] * sc), b2 = (int)rintf(f[4 * j + 1] * sc), c = (int)rintf(f[4 * j + 2] * sc), d = (int)rintf(f[4 * j + 3] * sc);
                o[j] = (unsigned)(a & 255) | ((unsigned)(b2 & 255) << 8) | ((unsigned)(c & 255) << 16) | ((unsigned)(d & 255) << 24); }
            uint4* op = (uint4*)(dst8 + (orow0 + n) * 512 + lane * 8);
            op[0] = make_uint4(o[0], o[1], o[2], o[3]); op[1] = make_uint4(o[4], o[5], o[6], o[7]);
            if (lane == 0) sdst[orow0 + n] = m * (1.0f / 127.0f);
        }
    }
}

#define TK_CE(x, y) do { const float hi_ = fmaxf(x, y), lo_ = fminf(x, y); x = hi_; y = lo_; } while (0)
#define TK_SORT2X16(a) do { TK_CE(a[0], a[1]); TK_CE(a[3], a[2]); TK_CE(a[4], a[5]); TK_CE(a[7], a[6]); TK_CE(a[8], a[9]); TK_CE(a[11], a[10]); TK_CE(a[12], a[13]); TK_CE(a[15], a[14]); TK_CE(a[0], a[2]); TK_CE(a[1], a[3]); TK_CE(a[6], a[4]); TK_CE(a[7], a[5]); TK_CE(a[8], a[10]); TK_CE(a[9], a[11]); TK_CE(a[14], a[12]); TK_CE(a[15], a[13]); TK_CE(a[0], a[1]); TK_CE(a[2], a[3]); TK_CE(a[5], a[4]); TK_CE(a[7], a[6]); TK_CE(a[8], a[9]); TK_CE(a[10], a[11]); TK_CE(a[13], a[12]); TK_CE(a[15], a[14]); TK_CE(a[0], a[4]); TK_CE(a[1], a[5]); TK_CE(a[2], a[6]); TK_CE(a[3], a[7]); TK_CE(a[12], a[8]); TK_CE(a[13], a[9]); TK_CE(a[14], a[10]); TK_CE(a[15], a[11]); TK_CE(a[0], a[2]); TK_CE(a[1], a[3]); TK_CE(a[4], a[6]); TK_CE(a[5], a[7]); TK_CE(a[10], a[8]); TK_CE(a[11], a[9]); TK_CE(a[14], a[12]); TK_CE(a[15], a[13]); TK_CE(a[0], a[1]); TK_CE(a[2], a[3]); TK_CE(a[4], a[5]); TK_CE(a[6], a[7]); TK_CE(a[9], a[8]); TK_CE(a[11], a[10]); TK_CE(a[13], a[12]); TK_CE(a[15], a[14]); TK_CE(a[0], a[8]); TK_CE(a[1], a[9]); TK_CE(a[2], a[10]); TK_CE(a[3], a[11]); TK_CE(a[4], a[12]); TK_CE(a[5], a[13]); TK_CE(a[6], a[14]); TK_CE(a[7], a[15]); TK_CE(a[0], a[4]); TK_CE(a[1], a[5]); TK_CE(a[2], a[6]); TK_CE(a[3], a[7]); TK_CE(a[8], a[12]); TK_CE(a[9], a[13]); TK_CE(a[10], a[14]); TK_CE(a[11], a[15]); TK_CE(a[0], a[2]); TK_CE(a[1], a[3]); TK_CE(a[4], a[6]); TK_CE(a[5], a[7]); TK_CE(a[8], a[10]); TK_CE(a[9], a[11]); TK_CE(a[12], a[14]); TK_CE(a[13], a[15]); TK_CE(a[0], a[1]); TK_CE(a[2], a[3]); TK_CE(a[4], a[5]); TK_CE(a[6], a[7]); TK_CE(a[8], a[9]); TK_CE(a[10], a[11]); TK_CE(a[12], a[13]); TK_CE(a[14], a[15]); TK_CE(a[16], a[17]); TK_CE(a[19], a[18]); TK_CE(a[20], a[21]); TK_CE(a[23], a[22]); TK_CE(a[24], a[25]); TK_CE(a[27], a[26]); TK_CE(a[28], a[29]); TK_CE(a[31], a[30]); TK_CE(a[16], a[18]); TK_CE(a[17], a[19]); TK_CE(a[22], a[20]); TK_CE(a[23], a[21]); TK_CE(a[24], a[26]); TK_CE(a[25], a[27]); TK_CE(a[30], a[28]); TK_CE(a[31], a[29]); TK_CE(a[16], a[17]); TK_CE(a[18], a[19]); TK_CE(a[21], a[20]); TK_CE(a[23], a[22]); TK_CE(a[24], a[25]); TK_CE(a[26], a[27]); TK_CE(a[29], a[28]); TK_CE(a[31], a[30]); TK_CE(a[16], a[20]); TK_CE(a[17], a[21]); TK_CE(a[18], a[22]); TK_CE(a[19], a[23]); TK_CE(a[28], a[24]); TK_CE(a[29], a[25]); TK_CE(a[30], a[26]); TK_CE(a[31], a[27]); TK_CE(a[16], a[18]); TK_CE(a[17], a[19]); TK_CE(a[20], a[22]); TK_CE(a[21], a[23]); TK_CE(a[26], a[24]); TK_CE(a[27], a[25]); TK_CE(a[30], a[28]); TK_CE(a[31], a[29]); TK_CE(a[16], a[17]); TK_CE(a[18], a[19]); TK_CE(a[20], a[21]); TK_CE(a[22], a[23]); TK_CE(a[25], a[24]); TK_CE(a[27], a[26]); TK_CE(a[29], a[28]); TK_CE(a[31], a[30]); TK_CE(a[16], a[24]); TK_CE(a[17], a[25]); TK_CE(a[18], a[26]); TK_CE(a[19], a[27]); TK_CE(a[20], a[28]); TK_CE(a[21], a[29]); TK_CE(a[22], a[30]); TK_CE(a[23], a[31]); TK_CE(a[16], a[20]); TK_CE(a[17], a[21]); TK_CE(a[18], a[22]); TK_CE(a[19], a[23]); TK_CE(a[24], a[28]); TK_CE(a[25], a[29]); TK_CE(a[26], a[30]); TK_CE(a[27], a[31]); TK_CE(a[16], a[18]); TK_CE(a[17], a[19]); TK_CE(a[20], a[22]); TK_CE(a[21], a[23]); TK_CE(a[24], a[26]); TK_CE(a[25], a[27]); TK_CE(a[28], a[30]); TK_CE(a[29], a[31]); TK_CE(a[16], a[17]); TK_CE(a[18], a[19]); TK_CE(a[20], a[21]); TK_CE(a[22], a[23]); TK_CE(a[24], a[25]); TK_CE(a[26], a[27]); TK_CE(a[28], a[29]); TK_CE(a[30], a[31]); } while (0)
#define TK_MERGE16(c) do { TK_CE(c[0], c[8]); TK_CE(c[1], c[9]); TK_CE(c[2], c[10]); TK_CE(c[3], c[11]); TK_CE(c[4], c[12]); TK_CE(c[5], c[13]); TK_CE(c[6], c[14]); TK_CE(c[7], c[15]); TK_CE(c[0], c[4]); TK_CE(c[1], c[5]); TK_CE(c[2], c[6]); TK_CE(c[3], c[7]); TK_CE(c[8], c[12]); TK_CE(c[9], c[13]); TK_CE(c[10], c[14]); TK_CE(c[11], c[15]); TK_CE(c[0], c[2]); TK_CE(c[1], c[3]); TK_CE(c[4], c[6]); TK_CE(c[5], c[7]); TK_CE(c[8], c[10]); TK_CE(c[9], c[11]); TK_CE(c[12], c[14]); TK_CE(c[13], c[15]); TK_CE(c[0], c[1]); TK_CE(c[2], c[3]); TK_CE(c[4], c[5]); TK_CE(c[6], c[7]); TK_CE(c[8], c[9]); TK_CE(c[10], c[11]); TK_CE(c[12], c[13]); TK_CE(c[14], c[15]); } while (0)
#define TK_SORT16(a) do { TK_CE(a[0], a[13]); TK_CE(a[1], a[12]); TK_CE(a[2], a[15]); TK_CE(a[3], a[14]); TK_CE(a[4], a[8]); TK_CE(a[5], a[6]); TK_CE(a[7], a[11]); TK_CE(a[9], a[10]); TK_CE(a[0], a[5]); TK_CE(a[1], a[7]); TK_CE(a[2], a[9]); TK_CE(a[3], a[4]); TK_CE(a[6], a[13]); TK_CE(a[8], a[14]); TK_CE(a[10], a[15]); TK_CE(a[11], a[12]); TK_CE(a[0], a[1]); TK_CE(a[2], a[3]); TK_CE(a[4], a[5]); TK_CE(a[6], a[8]); TK_CE(a[7], a[9]); TK_CE(a[10], a[11]); TK_CE(a[12], a[13]); TK_CE(a[14], a[15]); TK_CE(a[0], a[2]); TK_CE(a[1], a[3]); TK_CE(a[4], a[10]); TK_CE(a[5], a[11]); TK_CE(a[6], a[7]); TK_CE(a[8], a[9]); TK_CE(a[12], a[14]); TK_CE(a[13], a[15]); TK_CE(a[1], a[2]); TK_CE(a[3], a[12]); TK_CE(a[4], a[6]); TK_CE(a[5], a[7]); TK_CE(a[8], a[10]); TK_CE(a[9], a[11]); TK_CE(a[13], a[14]); TK_CE(a[1], a[4]); TK_CE(a[2], a[6]); TK_CE(a[5], a[8]); TK_CE(a[7], a[10]); TK_CE(a[9], a[13]); TK_CE(a[11], a[14]); TK_CE(a[2], a[4]); TK_CE(a[3], a[6]); TK_CE(a[9], a[12]); TK_CE(a[11], a[13]); TK_CE(a[3], a[5]); TK_CE(a[6], a[8]); TK_CE(a[7], a[9]); TK_CE(a[10], a[12]); TK_CE(a[3], a[4]); TK_CE(a[5], a[6]); TK_CE(a[7], a[8]); TK_CE(a[9], a[10]); TK_CE(a[11], a[12]); TK_CE(a[6], a[7]); TK_CE(a[8], a[9]); } while (0)
#define TK_SORT16H(a) do { TK_CE(a[16 + 0], a[16 + 13]); TK_CE(a[16 + 1], a[16 + 12]); TK_CE(a[16 + 2], a[16 + 15]); TK_CE(a[16 + 3], a[16 + 14]); TK_CE(a[16 + 4], a[16 + 8]); TK_CE(a[16 + 5], a[16 + 6]); TK_CE(a[16 + 7], a[16 + 11]); TK_CE(a[16 + 9], a[16 + 10]); TK_CE(a[16 + 0], a[16 + 5]); TK_CE(a[16 + 1], a[16 + 7]); TK_CE(a[16 + 2], a[16 + 9]); TK_CE(a[16 + 3], a[16 + 4]); TK_CE(a[16 + 6], a[16 + 13]); TK_CE(a[16 + 8], a[16 + 14]); TK_CE(a[16 + 10], a[16 + 15]); TK_CE(a[16 + 11], a[16 + 12]); TK_CE(a[16 + 0], a[16 + 1]); TK_CE(a[16 + 2], a[16 + 3]); TK_CE(a[16 + 4], a[16 + 5]); TK_CE(a[16 + 6], a[16 + 8]); TK_CE(a[16 + 7], a[16 + 9]); TK_CE(a[16 + 10], a[16 + 11]); TK_CE(a[16 + 12], a[16 + 13]); TK_CE(a[16 + 14], a[16 + 15]); TK_CE(a[16 + 0], a[16 + 2]); TK_CE(a[16 + 1], a[16 + 3]); TK_CE(a[16 + 4], a[16 + 10]); TK_CE(a[16 + 5], a[16 + 11]); TK_CE(a[16 + 6], a[16 + 7]); TK_CE(a[16 + 8], a[16 + 9]); TK_CE(a[16 + 12], a[16 + 14]); TK_CE(a[16 + 13], a[16 + 15]); TK_CE(a[16 + 1], a[16 + 2]); TK_CE(a[16 + 3], a[16 + 12]); TK_CE(a[16 + 4], a[16 + 6]); TK_CE(a[16 + 5], a[16 + 7]); TK_CE(a[16 + 8], a[16 + 10]); TK_CE(a[16 + 9], a[16 + 11]); TK_CE(a[16 + 13], a[16 + 14]); TK_CE(a[16 + 1], a[16 + 4]); TK_CE(a[16 + 2], a[16 + 6]); TK_CE(a[16 + 5], a[16 + 8]); TK_CE(a[16 + 7], a[16 + 10]); TK_CE(a[16 + 9], a[16 + 13]); TK_CE(a[16 + 11], a[16 + 14]); TK_CE(a[16 + 2], a[16 + 4]); TK_CE(a[16 + 3], a[16 + 6]); TK_CE(a[16 + 9], a[16 + 12]); TK_CE(a[16 + 11], a[16 + 13]); TK_CE(a[16 + 3], a[16 + 5]); TK_CE(a[16 + 6], a[16 + 8]); TK_CE(a[16 + 7], a[16 + 9]); TK_CE(a[16 + 10], a[16 + 12]); TK_CE(a[16 + 3], a[16 + 4]); TK_CE(a[16 + 5], a[16 + 6]); TK_CE(a[16 + 7], a[16 + 8]); TK_CE(a[16 + 9], a[16 + 10]); TK_CE(a[16 + 11], a[16 + 12]); TK_CE(a[16 + 6], a[16 + 7]); TK_CE(a[16 + 8], a[16 + 9]); } while (0)
#define TK_SORT13(a) do { TK_CE(a[1], a[12]); TK_CE(a[4], a[8]); TK_CE(a[5], a[6]); TK_CE(a[7], a[11]); TK_CE(a[9], a[10]); TK_CE(a[0], a[5]); TK_CE(a[1], a[7]); TK_CE(a[2], a[9]); TK_CE(a[3], a[4]); TK_CE(a[11], a[12]); TK_CE(a[0], a[1]); TK_CE(a[2], a[3]); TK_CE(a[4], a[5]); TK_CE(a[6], a[8]); TK_CE(a[7], a[9]); TK_CE(a[10], a[11]); TK_CE(a[0], a[2]); TK_CE(a[1], a[3]); TK_CE(a[4], a[10]); TK_CE(a[5], a[11]); TK_CE(a[6], a[7]); TK_CE(a[8], a[9]); TK_CE(a[1], a[2]); TK_CE(a[3], a[12]); TK_CE(a[4], a[6]); TK_CE(a[5], a[7]); TK_CE(a[8], a[10]); TK_CE(a[9], a[11]); TK_CE(a[1], a[4]); TK_CE(a[2], a[6]); TK_CE(a[5], a[8]); TK_CE(a[7], a[10]); TK_CE(a[2], a[4]); TK_CE(a[3], a[6]); TK_CE(a[9], a[12]); TK_CE(a[3], a[5]); TK_CE(a[6], a[8]); TK_CE(a[7], a[9]); TK_CE(a[10], a[12]); TK_CE(a[3], a[4]); TK_CE(a[5], a[6]); TK_CE(a[7], a[8]); TK_CE(a[9], a[10]); TK_CE(a[11], a[12]); TK_CE(a[6], a[7]); TK_CE(a[8], a[9]); } while (0)
#undef TK_CE
__device__ __forceinline__ void tk_ce(float& x, float& y) { float hi, lo; asm("v_max_f32 %0, %2, %3\n\tv_min_f32 %1, %2, %3" : "=&v"(hi), "=v"(lo) : "v"(x), "v"(y)); x = hi; y = lo; }
#define TK_CE(x, y) tk_ce(x, y)
__device__ __forceinline__ float tk_max(float x, float y) { float r; asm("v_max_f32 %0, %1, %2" : "=v"(r) : "v"(x), "v"(y)); return r; }
__device__ __forceinline__ float tk_sel(float a, float b, unsigned long long m) { float r; asm("v_cndmask_b32 %0, %1, %2, %3" : "=v"(r) : "v"(a), "v"(b), "s"(m)); return r; }
__device__ __forceinline__ float tk_sel4(float a0, float a1, float a2, float a3) {
    return tk_sel(tk_sel(a0, a1, 0xFFFF0000FFFF0000ull), tk_sel(a2, a3, 0xFFFF0000FFFF0000ull), 0xFFFFFFFF00000000ull); }
typedef __attribute__((ext_vector_type(2))) __bf16 bf16x2_t;
__device__ __forceinline__ float dot2bf(unsigned a, unsigned b, float acc) { return __builtin_amdgcn_fdot2_f32_bf16(__builtin_bit_cast(bf16x2_t, a), __builtin_bit_cast(bf16x2_t, b), acc, false); }
template <class VA, class VB> __device__ __forceinline__ float dot8bf(const VA a, const VB b, float acc) { acc = dot2bf(a.x, b.x, acc); acc = dot2bf(a.y, b.y, acc); acc = dot2bf(a.z, b.z, acc); return dot2bf(a.w, b.w, acc); }
__device__ __forceinline__ float wave_sum(float v) { return wave_sum_f(v); }
__device__ __forceinline__ unsigned pack2bf(float lo, float hi) { return (unsigned)f2bf(lo) | ((unsigned)f2bf(hi) << 16); }

__device__ __forceinline__ void cvt_stream(const float* __restrict__ src, bf16_t* __restrict__ dst, size_t n4, int tix) {
    for (size_t i = (size_t)blockIdx.x * NTHR + tix; i < n4; i += (size_t)gridDim.x * NTHR) {
        const float4 v = ((const float4*)src)[i]; uint2 o; o.x = pack2bf(v.x, v.y); o.y = pack2bf(v.z, v.w); ((uint2*)dst)[i] = o; }
}

#define SK_ROWB 272
#define TK2_TAB 71680
__device__ __forceinline__ float sel4f(int g, float a0, float a1, float a2, float a3) { return g == 0 ? a0 : (g == 1 ? a1 : (g == 2 ? a2 : a3)); }
struct TopkStage { const float* sk; unsigned char* lds;
    __device__ __forceinline__ void operator()(int i0) const {
        for (int idx = i0; idx < 2 * 128 * 32; idx += NTHR - 64) { const float4 v = ((const float4*)sk)[idx]; const int row = idx >> 5, c4 = idx & 31;
            uint2 o; o.x = pack2bf(v.x, v.y); o.y = pack2bf(v.z, v.w); *(uint2*)(lds + row * SK_ROWB + c4 * 8) = o; } } };
__device__ __forceinline__ void phase_topk(const bf16_t* __restrict__ Qb, const float* __restrict__ sk, unsigned short* __restrict__ E, float* __restrict__ G, unsigned char* lds,
                                           const float* __restrict__ SU = nullptr, const float* __restrict__ SV = nullptr, float* __restrict__ SUE = nullptr) {
    const int tix = otid();
    const int lane = tix & 63, w = tix >> 6, tok = lane & 15, g = lane >> 4;
    constexpr int PI[4][13] = {{0,0,0,0,0,0,0,0,0,0,0,0,0}, {0,0,0,1,1,1,1,1,1,1,1,2,2}, {2,2,2,3,3,3,3,4,4,4,5,5,6}, {6,7,7,8,9,10,11,12,13,14,15,0,0}};
    constexpr int PJ[4][13] = {{0,1,2,3,4,5,6,7,8,9,10,11,12}, {13,14,15,0,1,2,3,4,5,6,7,0,1}, {2,3,4,0,1,2,3,0,1,2,0,1,0}, {1,0,1,0,0,0,0,0,0,0,0,0,0}};
    const float NINF = -INFINITY;
    for (int tile = blockIdx.x; tile < T_ / 16; tile += gridDim.x) {
        const int t0 = tile * 16;
        const bf16_t* qrow = Qb + (size_t)(t0 + tok) * 2048 + w * 256 + g * 8;
        pg8::bf16x8 bq[2][4];
#pragma unroll
        for (int pp = 0; pp < 2; ++pp)
#pragma unroll
            for (int ks = 0; ks < 4; ++ks) bq[pp][ks] = *(const pg8::bf16x8*)(qrow + pp * 128 + ks * 32);
        float top[2][16];
#pragma unroll
        for (int pp = 0; pp < 2; ++pp) {
            pg8::f32x4 acc[8];
#pragma unroll
            for (int kt = 0; kt < 8; ++kt) { acc[kt] = (pg8::f32x4){0.f, 0.f, 0.f, 0.f};
#pragma unroll
                for (int ks = 0; ks < 4; ++ks) { const pg8::bf16x8 a = *(const pg8::bf16x8*)(lds + (pp * 128 + kt * 16 + tok) * SK_ROWB + (ks * 32 + g * 8) * 2);
                    acc[kt] = __builtin_amdgcn_mfma_f32_16x16x32_bf16(a, bq[pp][ks], acc[kt], 0, 0, 0); }
                if (kt & 1) __builtin_amdgcn_sched_barrier(0); }
            float sc[32];
#pragma unroll
            for (int kt = 0; kt < 8; ++kt)
#pragma unroll
                for (int r = 0; r < 4; ++r) sc[kt * 4 + r] = __uint_as_float((__float_as_uint(acc[kt][r]) & ~127u) | (unsigned)(kt * 16 + g * 4 + r));
            TK_SORT16(sc); TK_SORT16H(sc);
            float c[16];
#pragma unroll
            for (int i = 0; i < 16; ++i) c[i] = tk_max(sc[i], sc[31 - i]);
            TK_MERGE16(c);
#pragma unroll
            for (int st = 16; st <= 32; st <<= 1) { float pr[16];
#pragma unroll
                for (int i = 0; i < 16; ++i) pr[i] = __shfl_xor(c[15 - i], st);
#pragma unroll
                for (int i = 0; i < 16; ++i) c[i] = tk_max(c[i], pr[i]);
                TK_MERGE16(c); }
#pragma unroll
            for (int i = 0; i < 16; ++i) top[pp][i] = c[i];
        }
        float cs[16];
        unsigned* ctab = (unsigned*)(lds + TK2_TAB + w * 2048) + lane;
        unsigned cprev = 0;
#pragma unroll
        for (int k = 0; k < 13; ++k) {
            const float a = tk_sel4(top[0][PI[0][k]], top[0][PI[1][k]], top[0][PI[2][k]], top[0][PI[3][k]]);
            const float b = tk_sel4(top[1][PJ[0][k]], top[1][PJ[1][k]], top[1][PJ[2][k]], top[1][PJ[3][k]]);
            const unsigned ua = __float_as_uint(a), ub = __float_as_uint(b);
            const float sum = __uint_as_float(ua & ~127u) + __uint_as_float(ub & ~127u);
            float c = __uint_as_float((__float_as_uint(sum) & ~63u) | (unsigned)(g * 16 + k));
            if (k >= 11) c = (g == 3) ? NINF : c;
            cs[k] = c;
            const unsigned ce = ((ua & 127u) << 7) | (ub & 127u);
            if (k & 1) ctab[(k >> 1) * 64] = cprev | (ce << 16); else cprev = ce;
        }
        ctab[6 * 64] = cprev;
        cs[13] = NINF; cs[14] = NINF; cs[15] = NINF;
        TK_SORT13(cs);
#pragma unroll
        for (int st = 16; st <= 32; st <<= 1) { float pr[16];
#pragma unroll
            for (int i = 0; i < 16; ++i) pr[i] = __shfl_xor(cs[15 - i], st);
#pragma unroll
            for (int i = 0; i < 16; ++i) cs[i] = tk_max(cs[i], pr[i]);
            TK_MERGE16(cs); }
        const float cv0 = __uint_as_float(__float_as_uint(cs[0]) & ~63u);
        const unsigned char* cbase = lds + TK2_TAB + w * 2048 + tok * 4;
        int eo4[4]; float ex4[4]; float sum = 0.f;
#pragma unroll
        for (int j = 0; j < 4; ++j) {
            const unsigned wb = __float_as_uint(tk_sel4(cs[j], cs[4 + j], cs[8 + j], cs[12 + j]));
            const unsigned id = wb & 63u;
            eo4[j] = (int)((*(const unsigned*)(cbase + ((id & 14u) << 7) + ((id & 48u) << 2)) >> ((id & 1u) << 4)) & 0xFFFFu);
            ex4[j] = expf(__uint_as_float(wb & ~63u) - cv0); sum += ex4[j];
        }
        sum = rows4_sum(sum);
        const float inv = 1.0f / sum;
        int4 eout; float4 gout;
        eout.x = eo4[0]; eout.y = eo4[1]; eout.z = eo4[2]; eout.w = eo4[3];
        gout.x = ex4[0] * inv; gout.y = ex4[1] * inv; gout.z = ex4[2] * inv; gout.w = ex4[3] * inv;
        const size_t o = (size_t)(t0 + tok) * 128 + w * 16 + g * 4;
        if (SUE) { gout.x *= SV[eout.x]; gout.y *= SV[eout.y]; gout.z *= SV[eout.z]; gout.w *= SV[eout.w];
            *(float4*)(SUE + o) = make_float4(SU[eout.x], SU[eout.y], SU[eout.z], SU[eout.w]); }
        *(uint2*)(E + o) = make_uint2((unsigned)eout.x | ((unsigned)eout.y << 16), (unsigned)eout.z | ((unsigned)eout.w << 16)); *(float4*)(G + o) = gout;
    }
}

typedef unsigned u4q_t __attribute__((ext_vector_type(4)));
typedef float f2q_t __attribute__((ext_vector_type(2)));
template <int CTRL> __device__ __forceinline__ int dpp_i(int v) { return __builtin_amdgcn_update_dpp(0, v, CTRL, 0xf, 0xf, true); }
__device__ __forceinline__ int row_sum_i(int v) { v += dpp_i<0xB1>(v); v += dpp_i<0x4E>(v); v += dpp_i<0x141>(v); v += dpp_i<0x140>(v); return v; }

template <bool ADD> __device__ __forceinline__ void phase_lnq(const bf16_t* __restrict__ inb, const bf16_t* __restrict__ addb, const float* __restrict__ gam, const float* __restrict__ bet,
                                                              float* __restrict__ outf, bf16_t* __restrict__ outb, unsigned* __restrict__ outq, float* __restrict__ outs) {
    constexpr int RB = 2;
    const int tix = otid();
    const int lane = tix & 63, w = tix >> 6;
    const int rstep = gridDim.x * 8;
    for (int r0 = blockIdx.x * 8 + w; r0 < T_; r0 += rstep * RB) {
        uint4 xb4[RB][4], yb4[RB][ADD ? 4 : 1];
#pragma unroll
        for (int k = 0; k < RB; ++k) { const int t = (r0 + k * rstep < T_) ? r0 + k * rstep : r0;
#pragma unroll
            for (int i = 0; i < 4; ++i) { const size_t o = (size_t)t * D_ + i * 512 + lane * 8;
                xb4[k][i] = *(const uint4*)(inb + o);
                if (ADD) yb4[k][i] = *(const uint4*)(addb + o); } }
#pragma unroll
        for (int k = 0; k < RB; ++k) { const int t = r0 + k * rstep;
            if (t < T_) {
                float v[4][8]; float s = 0.f;
#pragma unroll
                for (int i = 0; i < 4; ++i) { const uint4 x = xb4[k][i];
                    v[i][0] = __uint_as_float(x.x << 16); v[i][1] = __uint_as_float(x.x & 0xffff0000u); v[i][2] = __uint_as_float(x.y << 16); v[i][3] = __uint_as_float(x.y & 0xffff0000u);
                    v[i][4] = __uint_as_float(x.z << 16); v[i][5] = __uint_as_float(x.z & 0xffff0000u); v[i][6] = __uint_as_float(x.w << 16); v[i][7] = __uint_as_float(x.w & 0xffff0000u);
                    if (ADD) { const uint4 y = yb4[k][ADD ? i : 0];
                        v[i][0] = ALPHA_ * v[i][0] + __uint_as_float(y.x << 16); v[i][1] = ALPHA_ * v[i][1] + __uint_as_float(y.x & 0xffff0000u);
                        v[i][2] = ALPHA_ * v[i][2] + __uint_as_float(y.y << 16); v[i][3] = ALPHA_ * v[i][3] + __uint_as_float(y.y & 0xffff0000u);
                        v[i][4] = ALPHA_ * v[i][4] + __uint_as_float(y.z << 16); v[i][5] = ALPHA_ * v[i][5] + __uint_as_float(y.z & 0xffff0000u);
                        v[i][6] = ALPHA_ * v[i][6] + __uint_as_float(y.w << 16); v[i][7] = ALPHA_ * v[i][7] + __uint_as_float(y.w & 0xffff0000u); }
#pragma unroll
                    for (int j = 0; j < 8; ++j) s += v[i][j]; }
                s = wave_sum(s);
                const float mu = s * (1.0f / D_);
                float q = 0.f;
#pragma unroll
                for (int i = 0; i < 4; ++i)
#pragma unroll
                    for (int j = 0; j < 8; ++j) { v[i][j] -= mu; q += v[i][j] * v[i][j]; }
                q = wave_sum(q);
                const float rstd = rsqrtf(q * (1.0f / D_) + LN_EPS_);
                float m = 0.f;
#pragma unroll
                for (int i = 0; i < 4; ++i) { const int c = i * 512 + lane * 8;
                    const float4 g0 = *(const float4*)(gam + c), g1 = *(const float4*)(gam + c + 4), b0 = *(const float4*)(bet + c), b1 = *(const float4*)(bet + c + 4);
                    const float gg[8] = {g0.x, g0.y, g0.z, g0.w, g1.x, g1.y, g1.z, g1.w}, bb[8] = {b0.x, b0.y, b0.z, b0.w, b1.x, b1.y, b1.z, b1.w};
#pragma unroll
                    for (int j = 0; j < 8; ++j) { v[i][j] = v[i][j] * rstd * gg[j] + bb[j]; m = fmaxf(m, fabsf(v[i][j])); }
                    if (outf) { *(float4*)(outf + (size_t)t * D_ + c) = make_float4(v[i][0], v[i][1], v[i][2], v[i][3]); *(float4*)(outf + (size_t)t * D_ + c + 4) = make_float4(v[i][4], v[i][5], v[i][6], v[i][7]); }
                    if (outb) *(uint4*)(outb + (size_t)t * D_ + c) = make_uint4(pack2bf(v[i][0], v[i][1]), pack2bf(v[i][2], v[i][3]), pack2bf(v[i][4], v[i][5]), pack2bf(v[i][6], v[i][7])); }
                if (outq) {
                    m = wave_max_f(m);
                    const float sc = m > 0.f ? 119.0f / m : 0.f;
#pragma unroll
                    for (int i = 0; i < 4; ++i) { int qv[8];
#pragma unroll
                        for (int j = 0; j < 8; ++j) qv[j] = (int)rintf(v[i][j] * sc) & 255;
                        *(uint2*)((unsigned char*)outq + (size_t)t * 2048 + i * 512 + lane * 8) =
                            make_uint2((unsigned)qv[0] | ((unsigned)qv[1] << 8) | ((unsigned)qv[2] << 16) | ((unsigned)qv[3] << 24), (unsigned)qv[4] | ((unsigned)qv[5] << 8) | ((unsigned)qv[6] << 16) | ((unsigned)qv[7] << 24)); }
                    if (lane == 0) outs[t] = m * (1.0f / 119.0f);
                }
            }
        }
    }
}

#define U8_COMP(RR, xx, zz) do { _Pragma("unroll") for (int j = 0; j < 16; ++j) { \
        int d = __builtin_amdgcn_sdot4((int)RR[j].x, (int)xx.x, 0, false); d = __builtin_amdgcn_sdot4((int)RR[j].y, (int)xx.y, d, false); \
        d = __builtin_amdgcn_sdot4((int)RR[j].z, (int)xx.z, d, false); d = __builtin_amdgcn_sdot4((int)RR[j].w, (int)xx.w, d, false); \
        d = row_sum_i(d); zz = (L == j) ? d : zz; } } while (0)
__device__ __forceinline__ unsigned permb(unsigned hi, unsigned lo, unsigned sel) { return __builtin_amdgcn_perm(hi, lo, sel); }
__device__ __forceinline__ void phase_quant_tables_i8(const float* __restrict__ pu, const float* __restrict__ pv, unsigned* __restrict__ Uq, unsigned* __restrict__ Vq,
                                                      float* __restrict__ SU, float* __restrict__ SV, int bid, int nb_, int vbeg, int vend) {
    const int tix = otid();
    const int lane = tix & 63, w = tix >> 6;
    for (int vr0 = vbeg + (bid * 8 + w) * 2; vr0 < vend; vr0 += nb_ * 16) {
        float4 v[2][8]; float m[2] = {0.f, 0.f};
#pragma unroll
        for (int k = 0; k < 2; ++k) { const int vr = (vr0 + k < vend) ? vr0 + k : vr0; const int tab = (vr >> 14) & 1, rr = ((vr >> 15) << 14) | (vr & 16383);
            const float* src = (tab ? pv : pu) + (size_t)rr * 2048 + lane * 8;
#pragma unroll
            for (int i = 0; i < 8; ++i) v[k][i] = *(const float4*)(src + (i >> 1) * 512 + (i & 1) * 4); }
#pragma unroll
        for (int k = 0; k < 2; ++k) {
#pragma unroll
            for (int i = 0; i < 8; ++i) m[k] = fmaxf(m[k], fmaxf(fmaxf(fabsf(v[k][i].x), fabsf(v[k][i].y)), fmaxf(fabsf(v[k][i].z), fabsf(v[k][i].w))));
            m[k] = wave_max_f(m[k]);
            const int vr = (vr0 + k < vend) ? vr0 + k : vr0; const int tab = (vr >> 14) & 1, rr = ((vr >> 15) << 14) | (vr & 16383);
            if (tab) {
                const float sc = m[k] > 0.f ? 127.0f / m[k] : 0.f;
                unsigned char* dst = (unsigned char*)Vq + (size_t)rr * 2048 + lane * 8;
#pragma unroll
                for (int bq = 0; bq < 4; ++bq) { unsigned o[2];
#pragma unroll
                    for (int h = 0; h < 2; ++h) { const float4 y = v[k][2 * bq + h]; const int a = (int)rintf(y.x * sc), b = (int)rintf(y.y * sc), c = (int)rintf(y.z * sc), d = (int)rintf(y.w * sc);
                        o[h] = (unsigned)(a & 255) | ((unsigned)(b & 255) << 8) | ((unsigned)(c & 255) << 16) | ((unsigned)(d & 255) << 24); }
                    *(uint2*)(dst + bq * 512) = make_uint2(o[0], o[1]); }
                if (lane == 0) SV[rr] = m[k] * (1.0f / 127.0f);
            } else {
                const float sc = m[k] > 0.f ? 7.0f / m[k] : 0.f;
                unsigned* dst = Uq + (size_t)rr * 256 + lane;
#pragma unroll
                for (int bq = 0; bq < 4; ++bq) { const float4 y0 = v[k][2 * bq], y1 = v[k][2 * bq + 1];
                    const unsigned lo = (unsigned)((int)rintf(y0.x * sc) & 15) | ((unsigned)((int)rintf(y0.y * sc) & 15) << 8) | ((unsigned)((int)rintf(y0.z * sc) & 15) << 16) | ((unsigned)((int)rintf(y0.w * sc) & 15) << 24);
                    const unsigned hi = (unsigned)((int)rintf(y1.x * sc) & 15) | ((unsigned)((int)rintf(y1.y * sc) & 15) << 8) | ((unsigned)((int)rintf(y1.z * sc) & 15) << 16) | ((unsigned)((int)rintf(y1.w * sc) & 15) << 24);
                    dst[bq * 64] = lo | (hi << 4); }
                if (lane == 0) SU[rr] = m[k] * (1.0f / 7.0f);
            }
        }
    }
}

__device__ __forceinline__ void wq_bf8_to_f(const uint4 v, float (&f)[8]) {
    f[0] = __uint_as_float(v.x << 16); f[1] = __uint_as_float(v.x & 0xffff0000u); f[2] = __uint_as_float(v.y << 16); f[3] = __uint_as_float(v.y & 0xffff0000u);
    f[4] = __uint_as_float(v.z << 16); f[5] = __uint_as_float(v.z & 0xffff0000u); f[6] = __uint_as_float(v.w << 16); f[7] = __uint_as_float(v.w & 0xffff0000u); }
__device__ __forceinline__ void phase_quant_wq(const bf16_t* __restrict__ WqT, unsigned* __restrict__ Wq8, float* __restrict__ SW, int nrows) {
    const int tix = otid();
    const int lane = tix & 63, w = tix >> 6;
    for (int r0 = ((int)blockIdx.x * 8 + w) * 2; r0 < nrows; r0 += (int)gridDim.x * 16) {
        uint4 v[2][4];
#pragma unroll
        for (int k = 0; k < 2; ++k)
#pragma unroll
            for (int i = 0; i < 4; ++i) v[k][i] = *(const uint4*)(WqT + (size_t)(r0 + k) * 2048 + i * 512 + lane * 8);
#pragma unroll
        for (int k = 0; k < 2; ++k) { float f[4][8]; float m = 0.f;
#pragma unroll
            for (int i = 0; i < 4; ++i) { wq_bf8_to_f(v[k][i], f[i]);
#pragma unroll
                for (int j = 0; j < 8; ++j) m = fmaxf(m, fabsf(f[i][j])); }
#pragma unroll
            for (int o = 32; o >= 1; o >>= 1) m = fmaxf(m, __shfl_xor(m, o));
            const float sc = m > 0.f ? 127.0f / m : 0.f;
#pragma unroll
            for (int i = 0; i < 4; ++i) { unsigned q[2];
#pragma unroll
                for (int h = 0; h < 2; ++h) { const int a = (int)rintf(f[i][4 * h] * sc), b = (int)rintf(f[i][4 * h + 1] * sc), c = (int)rintf(f[i][4 * h + 2] * sc), d = (int)rintf(f[i][4 * h + 3] * sc);
                    q[h] = (unsigned)(a & 255) | ((unsigned)(b & 255) << 8) | ((unsigned)(c & 255) << 16) | ((unsigned)(d & 255) << 24); }
                *(uint2*)(Wq8 + (size_t)(r0 + k) * 512 + i * 128 + lane * 2) = make_uint2(q[0], q[1]); }
            if (lane == 0) SW[r0 + k] = m * (1.0f / 127.0f);
        }
    }
}

#define V8I_LOAD(RR, WQ, lbp, kk0) do { WQ = *(const u4q_t*)((lbp) + 512 + sub * 32 + (kk0)); \
        _Pragma("unroll") for (int j4 = 0; j4 < 4; ++j4) { const u4q_t eo = *(const u4q_t*)((lbp) + (sub * 32 + (kk0) + j4 * 4) * 4); \
        RR[j4 * 4 + 0] = *(const u4q_t*)(vb + (eo.x + lofs)); RR[j4 * 4 + 1] = *(const u4q_t*)(vb + (eo.y + lofs)); RR[j4 * 4 + 2] = *(const u4q_t*)(vb + (eo.z + lofs)); RR[j4 * 4 + 3] = *(const u4q_t*)(vb + (eo.w + lofs)); } } while (0)
#define V8I_T4(A_, B_, C_, D_, wq_, c0) do { const unsigned P_ = permb(B_, A_, 0x05010400u), Q_ = permb(B_, A_, 0x07030602u), R_ = permb(D_, C_, 0x05010400u), S_ = permb(D_, C_, 0x07030602u); \
        acc[(c0) + 0] = __builtin_amdgcn_sdot4((int)permb(R_, P_, 0x05040100u), (int)(wq_), acc[(c0) + 0], false); acc[(c0) + 1] = __builtin_amdgcn_sdot4((int)permb(R_, P_, 0x07060302u), (int)(wq_), acc[(c0) + 1], false); \
        acc[(c0) + 2] = __builtin_amdgcn_sdot4((int)permb(S_, Q_, 0x05040100u), (int)(wq_), acc[(c0) + 2], false); acc[(c0) + 3] = __builtin_amdgcn_sdot4((int)permb(S_, Q_, 0x07060302u), (int)(wq_), acc[(c0) + 3], false); } while (0)
#define V8I_COMP(RR, WQ) do { _Pragma("unroll") for (int j4 = 0; j4 < 4; ++j4) { const unsigned wq_ = (j4 == 0 ? WQ.x : (j4 == 1 ? WQ.y : (j4 == 2 ? WQ.z : WQ.w))); \
        V8I_T4(RR[j4 * 4].x, RR[j4 * 4 + 1].x, RR[j4 * 4 + 2].x, RR[j4 * 4 + 3].x, wq_, 0); V8I_T4(RR[j4 * 4].y, RR[j4 * 4 + 1].y, RR[j4 * 4 + 2].y, RR[j4 * 4 + 3].y, wq_, 4); \
        V8I_T4(RR[j4 * 4].z, RR[j4 * 4 + 1].z, RR[j4 * 4 + 2].z, RR[j4 * 4 + 3].z, wq_, 8); V8I_T4(RR[j4 * 4].w, RR[j4 * 4 + 1].w, RR[j4 * 4 + 2].w, RR[j4 * 4 + 3].w, wq_, 12); } } while (0)
__device__ __forceinline__ void phase_peer_fin(const float* __restrict__ G, const float* __restrict__ SUE, const int* __restrict__ ZI, const float* __restrict__ SX,
                                               unsigned char* __restrict__ WQ, float* __restrict__ WSC, unsigned short* __restrict__ E) {
    const int tix = otid();
    const int lane = tix & 63, w = tix >> 6;
    for (int t = blockIdx.x * 8 + w; t < T_; t += gridDim.x * 8) {
        int i0 = 0, i1 = 0;
#pragma unroll
        for (int x = 0; x < 8; ++x) { const int2 zi = *(const int2*)(ZI + ((size_t)x * T_ + t) * 128 + 2 * lane); i0 += zi.x; i1 += zi.y; }
        const float sx = SX[t];
        const float2 su = *(const float2*)(SUE + (size_t)t * 128 + 2 * lane), gg = *(const float2*)(G + (size_t)t * 128 + 2 * lane);
        const unsigned ew = ((const unsigned*)E)[(size_t)t * 64 + lane];
        const float z0 = (float)i0 * (su.x * sx), z1 = (float)i1 * (su.y * sx);
        const float w0 = gelu_exact(z0) * gg.x, w1 = gelu_exact(z1) * gg.y;
        float wm = fmaxf(fabsf(w0), fabsf(w1));
        wm = wave_max_f(wm);
        const float qs = wm > 0.f ? 127.0f / wm : 0.f;
        const int q0 = (int)rintf(w0 * qs), q1 = (int)rintf(w1 * qs);
        ((unsigned short*)WQ)[(size_t)t * 64 + lane] = (unsigned short)((q0 & 255) | ((q1 & 255) << 8));
        const unsigned en = (q0 == 0 ? 0u : (ew & 0xFFFFu)) | (q1 == 0 ? 0u : (ew & 0xFFFF0000u));
        if (en != ew) ((unsigned*)E)[(size_t)t * 64 + lane] = en;
        if (lane == 0) WSC[t] = wm * (1.0f / 127.0f);
    }
}
struct V8KPre { unsigned ew; unsigned wq; float wsc; };
#define V8K_PLOAD(P_, tt) do { P_.ew = ((const unsigned*)E)[(size_t)(tt) * 64 + lane]; P_.wq = ((const unsigned*)WQ)[(size_t)(tt) * 32 + (lane & 31)]; P_.wsc = WSC[(tt)]; } while (0)
#define V8K_PFIN(P_, bsel, wsc_out) do { unsigned char* lb_ = lds + w * 2048 + (bsel) * 1024; wsc_out = P_.wsc; \
        *(uint2*)(lb_ + 8 * lane) = make_uint2((P_.ew & 0xFFFFu) * 2048u, (P_.ew >> 16) * 2048u); if (lane < 32) ((unsigned*)(lb_ + 512))[lane] = P_.wq; } while (0)
__device__ __forceinline__ void phase_gather_v8k(bf16_t* __restrict__ YB, const unsigned* __restrict__ Vq, const unsigned short* __restrict__ E, const unsigned char* __restrict__ WQ, const float* __restrict__ WSC,
                                                 unsigned char* lds) {
    const int tix = otid();
    const int lane = tix & 63, w = tix >> 6, L = lane & 15, sub = lane >> 4;
    for (int vblk = blockIdx.x; vblk < 256; vblk += gridDim.x) {
    const int X = vblk & 7, r = vblk >> 3, nr = 32, step = nr * 8;
    const char* vb = (const char*)Vq + X * 256; const unsigned lofs = (unsigned)L * 16u;
    int t = r * 8 + w; int buf = 0;
    float wsc = 0.f, wscn = 0.f;
    V8KPre P0, P1;
    V8K_PLOAD(P0, t);
    { const int t1 = (t + step < T_) ? t + step : t; V8K_PLOAD(P1, t1); }
    V8K_PFIN(P0, 0, wsc);
    u4q_t RA[16], RB[16]; u4q_t WA, WB;
    V8I_LOAD(RA, WA, lds + w * 2048, 0);
#pragma unroll 1
    for (; t < T_; t += step) {
        const int t2 = (t + 2 * step < T_) ? t + 2 * step : t;
        const unsigned char* lbp = lds + w * 2048 + buf * 1024;
        V8I_LOAD(RB, WB, lbp, 16);
        V8K_PLOAD(P0, t2);
        int acc[16];
#pragma unroll
        for (int i = 0; i < 16; ++i) acc[i] = 0;
        V8I_COMP(RA, WA);
        V8K_PFIN(P1, buf ^ 1, wscn);
        V8I_LOAD(RA, WA, lds + w * 2048 + (buf ^ 1) * 1024, 0);
        V8I_COMP(RB, WB);
        int s1[8], f4[4];
#pragma unroll
        for (int i = 0; i < 8; ++i) { const auto r_ = __builtin_amdgcn_permlane32_swap((unsigned)acc[i], (unsigned)acc[i + 8], false, false); s1[i] = (int)r_[0] + (int)r_[1]; }
#pragma unroll
        for (int i = 0; i < 4; ++i) { const auto r_ = __builtin_amdgcn_permlane16_swap((unsigned)s1[i], (unsigned)s1[i + 4], false, false); f4[i] = (int)r_[0] + (int)r_[1]; }
        { const size_t o = (size_t)t * D_ + X * 256 + L * 16 + sub * 4;
          typedef unsigned u2nt_t __attribute__((ext_vector_type(2)));
          const u2nt_t n0 = {pack2bf(wsc * (float)f4[0], wsc * (float)f4[1]), pack2bf(wsc * (float)f4[2], wsc * (float)f4[3])};
          __builtin_nontemporal_store(n0, (u2nt_t*)(YB + o)); }
        buf ^= 1; wsc = wscn; P1 = P0;
    }
    }
}
struct U8RPre { unsigned ew; u4q_t xs; };
#define U8R_PLOAD(P_, tt) do { P_.ew = ((const unsigned*)E)[(size_t)(tt) * 64 + lane]; P_.xs = *(const u4q_t*)((const char*)x1q + (size_t)(tt) * 2048 + X * 256 + L * 16); } while (0)
#define U8R_STAGE(P_, bsel) do { unsigned* lb_ = (unsigned*)(lds + w * 1024 + (bsel) * 512); *(uint2*)(lb_ + 2 * lane) = make_uint2((P_.ew & 0xFFFFu) * 2048u, (P_.ew >> 16) * 2048u); } while (0)
#define U8R_LOAD(RR, bsel, kk0) do { const unsigned* lb_ = (const unsigned*)(lds + w * 1024 + (bsel) * 512) + sub * 32 + (kk0); _Pragma("unroll") for (int j4 = 0; j4 < 4; ++j4) { const u4q_t eo = *(const u4q_t*)(lb_ + j4 * 4); \
        RR[j4 * 4 + 0] = *(const u4q_t*)(ub + eo.x); RR[j4 * 4 + 1] = *(const u4q_t*)(ub + eo.y); RR[j4 * 4 + 2] = *(const u4q_t*)(ub + eo.z); RR[j4 * 4 + 3] = *(const u4q_t*)(ub + eo.w); } } while (0)
__device__ __forceinline__ void phase_gather_u8r(const unsigned* __restrict__ x1q, const unsigned* __restrict__ Uq, const unsigned short* __restrict__ E, int* __restrict__ ZI, unsigned char* lds) {
    const int tix = otid();
    const int lane = tix & 63, w = tix >> 6, L = lane & 15, sub = lane >> 4;
    for (int vb = blockIdx.x; vb < 256; vb += gridDim.x) {
    const int X = vb & 7, r = vb >> 3, nr = 32, step = nr * 8;
    const char* ub = (const char*)Uq + X * 256 + L * 16;
    int t = r * 8 + w; int buf = 0;
    U8RPre P0, P1;
    U8R_PLOAD(P0, t);
    { const int t1 = (t + step < T_) ? t + step : t; U8R_PLOAD(P1, t1); }
    U8R_STAGE(P0, 0);
    u4q_t xs = P0.xs, xsn = P1.xs;
    u4q_t RA[16], RB[16];
    U8R_LOAD(RA, 0, 0);
#pragma unroll 1
    for (; t < T_; t += step) {
        const int t2 = (t + 2 * step < T_) ? t + 2 * step : t;
        U8R_LOAD(RB, buf, 16);
        U8R_PLOAD(P0, t2);
        int zA = 0, zB = 0;
        U8_COMP(RA, xs, zA);
        U8R_STAGE(P1, buf ^ 1);
        U8R_LOAD(RA, buf ^ 1, 0);
        U8_COMP(RB, xs, zB);
        int* zp = ZI + ((size_t)X * T_ + t) * 128 + sub * 32 + L;
        __builtin_nontemporal_store(zA, zp); __builtin_nontemporal_store(zB, zp + 16);
        buf ^= 1; xs = xsn; xsn = P0.xs; P1 = P0;
    }
    }
}
struct U4Pre { unsigned ew; u4q_t xa, xb; };
#define U4_PLOAD(P_, tt) do { P_.ew = ((const unsigned*)E)[(size_t)(tt) * 64 + lane]; const char* xp_ = (const char*)x1q + (size_t)(tt) * 2048 + X * 256 + L8 * 32; \
        P_.xa = *(const u4q_t*)xp_; P_.xb = *(const u4q_t*)(xp_ + 16); } while (0)
#define U4_STAGE(P_, bsel) do { unsigned* lb_ = (unsigned*)(lds + w * 1024 + (bsel) * 512); *(uint2*)(lb_ + 2 * lane) = make_uint2((P_.ew & 0xFFFFu) * 1024u, (P_.ew >> 16) * 1024u); } while (0)
#define U4_LOAD(RR, bsel) do { const unsigned* lb_ = (const unsigned*)(lds + w * 1024 + (bsel) * 512) + sub * 16; _Pragma("unroll") for (int j4 = 0; j4 < 4; ++j4) { const u4q_t eo = *(const u4q_t*)(lb_ + j4 * 4); \
        RR[j4 * 4 + 0] = *(const u4q_t*)(ub + (eo.x + lofs)); RR[j4 * 4 + 1] = *(const u4q_t*)(ub + (eo.y + lofs)); RR[j4 * 4 + 2] = *(const u4q_t*)(ub + (eo.z + lofs)); RR[j4 * 4 + 3] = *(const u4q_t*)(ub + (eo.w + lofs)); } } while (0)
#define U4_PLANE1(X0_, X1_, H_, L_) do { const unsigned s0_ = (((X0_) & 0x7F7F7F7Fu) + 0x08080808u) ^ ((X0_) & 0x80808080u), s1_ = (((X1_) & 0x7F7F7F7Fu) + 0x08080808u) ^ ((X1_) & 0x80808080u); \
        H_ = ((s0_ >> 4) & 0x0F0F0F0Fu) | (s1_ & 0xF0F0F0F0u); L_ = ((X0_) & 0x0F0F0F0Fu) | (((X1_) & 0x0F0F0F0Fu) << 4); } while (0)
#define U4_COMP(RR, xa_, xb_, zA_, zB_) do { \
        unsigned H0_, H1_, H2_, H3_, L0_, L1_, L2_, L3_; U4_PLANE1(xa_.x, xa_.y, H0_, L0_); U4_PLANE1(xa_.z, xa_.w, H1_, L1_); U4_PLANE1(xb_.x, xb_.y, H2_, L2_); U4_PLANE1(xb_.z, xb_.w, H3_, L3_); \
        int d_[16]; \
        _Pragma("unroll") for (int j = 0; j < 16; ++j) { \
            int dh = __builtin_amdgcn_sdot8((int)RR[j].x, (int)H0_, 0, false), dl = __builtin_amdgcn_sdot8((int)RR[j].x, (int)L0_, 0, false); \
            dh = __builtin_amdgcn_sdot8((int)RR[j].y, (int)H1_, dh, false); dl = __builtin_amdgcn_sdot8((int)RR[j].y, (int)L1_, dl, false); \
            dh = __builtin_amdgcn_sdot8((int)RR[j].z, (int)H2_, dh, false); dl = __builtin_amdgcn_sdot8((int)RR[j].z, (int)L2_, dl, false); \
            dh = __builtin_amdgcn_sdot8((int)RR[j].w, (int)H3_, dh, false); dl = __builtin_amdgcn_sdot8((int)RR[j].w, (int)L3_, dl, false); d_[j] = (dh << 4) + dl; } \
          \
        _Pragma("unroll") for (int h = 0; h < 16; h += 8) { \
            _Pragma("unroll") for (int j = 0; j < 4; ++j) { const int kp = (L8 & 4) ? d_[h + j + 4] : d_[h + j], gv = (L8 & 4) ? d_[h + j] : d_[h + j + 4]; d_[h + j] = kp + dpp_i<0x141>(gv); } \
            _Pragma("unroll") for (int j = 0; j < 2; ++j) { const int kp = (L8 & 2) ? d_[h + j + 2] : d_[h + j], gv = (L8 & 2) ? d_[h + j] : d_[h + j + 2]; d_[h + j] = kp + dpp_i<0x4E>(gv); } \
            { const int kp = (L8 & 1) ? d_[h + 1] : d_[h], gv = (L8 & 1) ? d_[h] : d_[h + 1]; d_[h] = kp + dpp_i<0xB1>(gv); } } \
        zA_ = d_[0]; zB_ = d_[8]; } while (0)
__device__ __forceinline__ void phase_gather_u4(const unsigned* __restrict__ x1q, const unsigned* __restrict__ Uq, const unsigned short* __restrict__ E, int* __restrict__ ZI, unsigned char* lds) {
    const int tix = otid();
    const int lane = tix & 63, w = tix >> 6, L8 = lane & 7, sub = lane >> 3;
    for (int vb = blockIdx.x; vb < 256; vb += gridDim.x) {
    const int X = vb & 7, r = vb >> 3, step = 256;
    const char* ub = (const char*)Uq + X * 128; const unsigned lofs = (unsigned)L8 * 16u;
    const int t0 = r * 8 + w;
    U4Pre P0, P1;
    U4_PLOAD(P0, t0); U4_PLOAD(P1, t0 + step);
    U4_STAGE(P0, 0);
    u4q_t RA[16], RB[16];
    U4_LOAD(RA, 0);
    u4q_t xAa = P0.xa, xAb = P0.xb;
#pragma unroll 1
    for (int k = 0; k < 32; k += 2) {
        const int tA = t0 + step * k, tB = tA + step;
        U4_STAGE(P1, 1); U4_LOAD(RB, 1);
        const u4q_t xBa = P1.xa, xBb = P1.xb;
        U4_PLOAD(P0, t0 + step * min(k + 2, 31));
        { int zA = 0, zB = 0; U4_COMP(RA, xAa, xAb, zA, zB);
          int* zp = ZI + ((size_t)X * T_ + tA) * 128 + sub * 16 + L8; __builtin_nontemporal_store(zA, zp); __builtin_nontemporal_store(zB, zp + 8); }
        U4_STAGE(P0, 0); U4_LOAD(RA, 0);
        xAa = P0.xa; xAb = P0.xb;
        U4_PLOAD(P1, t0 + step * min(k + 3, 31));
        { int zA = 0, zB = 0; U4_COMP(RB, xBa, xBb, zA, zB);
          int* zp = ZI + ((size_t)X * T_ + tB) * 128 + sub * 16 + L8; __builtin_nontemporal_store(zA, zp); __builtin_nontemporal_store(zB, zp + 8); }
    }
    }
}
__device__ __forceinline__ void phase_cvt_gatew(const float* __restrict__ wr, const float* __restrict__ wi, bf16_t* __restrict__ Wt, int bid, int nb_) {
    const int tix = otid();
    const int total = 2 * 2 * 8 * 2 * 128 * 128;
    for (int o = bid * NTHR + tix; o < total; o += nb_ * NTHR) {
        const int i = o & 127, j = (o >> 7) & 127, gate = (o >> 14) & 1, dh = (o >> 15) & 15, il = o >> 19;
        const float* src = gate ? wi : wr;
        Wt[o] = f2bf(src[(((size_t)il * 16 + dh) * 128 + i) * 128 + j]);
    }
}

#define EV_AS   0
#define EV_US   33792
#define EV_XS   0
#define EV_XCF  67584
#define EV_XCB  101376
#define EV_SEG  118784
#define EV_ROWF 132
#define EV_ROWB 272
__device__ __forceinline__ void phase_even_local(const bf16_t* __restrict__ Z, const float* __restrict__ cw  , const float* __restrict__ cb  ,
                                                 const bf16_t* __restrict__ Wt  , const float* __restrict__ br, const float* __restrict__ bi, const float* __restrict__ lam,
                                                 bf16_t* __restrict__ HL, bf16_t* __restrict__ CA, float* __restrict__ AGG, unsigned char* lds, int u0, int u1, int ustep) {
    const int tix = otid();
    const int lane = tix & 63, w = tix >> 6, tokl = lane & 15, g = lane >> 4;
    float* AS = (float*)(lds + EV_AS); float* US = (float*)(lds + EV_US); float* XS = (float*)(lds + EV_XS); float* XCF = (float*)(lds + EV_XCF);
    float* SEG = (float*)(lds + EV_SEG);
    uint4 pre[3];
#define EVL_PREFETCH(uu) do { const int dh_ = (uu) & 15, d_ = dh_ >> 3, h_ = dh_ & 7, c_ = (uu) >> 4; const int tb_ = d_ == 0 ? c_ * 64 - 3 : c_ * 64; \
        _Pragma("unroll") for (int i_ = 0; i_ < 3; ++i_) { const int idx_ = tix + i_ * NTHR; const int r_ = idx_ >> 4, c8_ = idx_ & 15; const int tt_ = tb_ + r_; \
            pre[i_] = make_uint4(0u, 0u, 0u, 0u); if (idx_ < 67 * 16 && tt_ >= 0 && tt_ < T_) pre[i_] = *(const uint4*)(Z + (size_t)tt_ * NZ_ + 3072 + h_ * 128 + c8_ * 8); } } while (0)
    int cur_dh = -1, cur_dhc = -1; pg8::bf16x8 af[2][4]; float sp[4], brr[4], bii[4]; float4 w0, w1, w2, w3, bb;
    if (u0 < u1) EVL_PREFETCH(u0);
    for (int u = u0; u < u1; u += ustep) {
        const int dh = u & 15, d = dh >> 3, h = dh & 7, c = u >> 4, t0 = c * 64;
        __syncthreads();
#pragma unroll
        for (int i = 0; i < 3; ++i) { const int idx = tix + i * NTHR; const int r = idx >> 4, c8 = idx & 15; const uint4 v = pre[i];
            if (idx < 67 * 16) {
                *(float4*)(XS + r * 128 + c8 * 8) = make_float4(__uint_as_float(v.x << 16), __uint_as_float(v.x & 0xffff0000u), __uint_as_float(v.y << 16), __uint_as_float(v.y & 0xffff0000u));
                *(float4*)(XS + r * 128 + c8 * 8 + 4) = make_float4(__uint_as_float(v.z << 16), __uint_as_float(v.z & 0xffff0000u), __uint_as_float(v.w << 16), __uint_as_float(v.w & 0xffff0000u)); } }
        if (u + ustep < u1) EVL_PREFETCH(u + ustep);
        __syncthreads();
        float4 xcv[4];
        { const int c4 = tix & 31, tg = tix >> 5; const int ch = h * 128 + c4 * 4;
          if (dh != cur_dhc) { cur_dhc = dh; w0 = *(const float4*)(cw + (d * 4 + 0) * 1024 + ch); w1 = *(const float4*)(cw + (d * 4 + 1) * 1024 + ch); w2 = *(const float4*)(cw + (d * 4 + 2) * 1024 + ch);
              w3 = *(const float4*)(cw + (d * 4 + 3) * 1024 + ch); bb = *(const float4*)(cb + d * 1024 + ch); }
          float4 xr[7];
#pragma unroll
          for (int r = 0; r < 7; ++r) xr[r] = *(const float4*)(XS + (tg * 4 + r) * 128 + c4 * 4);
#pragma unroll
          for (int k = 0; k < 4; ++k) { float4 o;
              o.x = bb.x + w0.x * xr[k].x + w1.x * xr[k + 1].x + w2.x * xr[k + 2].x + w3.x * xr[k + 3].x;
              o.y = bb.y + w0.y * xr[k].y + w1.y * xr[k + 1].y + w2.y * xr[k + 2].y + w3.y * xr[k + 3].y;
              o.z = bb.z + w0.z * xr[k].z + w1.z * xr[k + 1].z + w2.z * xr[k + 2].z + w3.z * xr[k + 3].z;
              o.w = bb.w + w0.w * xr[k].w + w1.w * xr[k + 1].w + w2.w * xr[k + 2].w + w3.w * xr[k + 3].w;
              xcv[k] = o; }
          __syncthreads();
#pragma unroll
          for (int k = 0; k < 4; ++k) { const int tl = tg * 4 + k;
              *(float4*)(XCF + tl * EV_ROWF + c4 * 4) = xcv[k];
              uint2 pk; pk.x = pack2bf(xcv[k].x, xcv[k].y); pk.y = pack2bf(xcv[k].z, xcv[k].w);
              *(uint2*)(lds + EV_XCB + tl * EV_ROWB + c4 * 8) = pk; } }
        __syncthreads();
        { if (dh != cur_dh) { cur_dh = dh;
              const bf16_t* wbase = Wt + ((size_t)(dh * 2) * 128 + w * 16 + tokl) * 128 + g * 8;
#pragma unroll
              for (int gt = 0; gt < 2; ++gt)
#pragma unroll
                  for (int ks = 0; ks < 4; ++ks) af[gt][ks] = *(const pg8::bf16x8*)(wbase + (size_t)gt * 128 * 128 + ks * 32);
              const int ch0 = h * 128 + w * 16 + g * 4;
              const float4 brv = *(const float4*)(br + d * 1024 + ch0), biv = *(const float4*)(bi + d * 1024 + ch0), lmv = *(const float4*)(lam + d * 1024 + ch0);
              sp[0] = log1pf(expf(-lmv.x)); sp[1] = log1pf(expf(-lmv.y)); sp[2] = log1pf(expf(-lmv.z)); sp[3] = log1pf(expf(-lmv.w));
              brr[0] = brv.x; brr[1] = brv.y; brr[2] = brv.z; brr[3] = brv.w; bii[0] = biv.x; bii[1] = biv.y; bii[2] = biv.z; bii[3] = biv.w; }
#pragma unroll
          for (int nt = 0; nt < 4; ++nt) {
              pg8::f32x4 accr = {0.f, 0.f, 0.f, 0.f}, acci = {0.f, 0.f, 0.f, 0.f};
#pragma unroll
              for (int ks = 0; ks < 4; ++ks) { const pg8::bf16x8 b = *(const pg8::bf16x8*)(lds + EV_XCB + (nt * 16 + tokl) * EV_ROWB + (ks * 32 + g * 8) * 2);
                  accr = __builtin_amdgcn_mfma_f32_16x16x32_bf16(af[0][ks], b, accr, 0, 0, 0);
                  acci = __builtin_amdgcn_mfma_f32_16x16x32_bf16(af[1][ks], b, acci, 0, 0, 0); }
              const int tl = nt * 16 + tokl;
              const float4 xv = *(const float4*)(XCF + tl * EV_ROWF + w * 16 + g * 4);
              const float xx[4] = {xv.x, xv.y, xv.z, xv.w};
              float av[4], uv[4];
#pragma unroll
              for (int r = 0; r < 4; ++r) {
                  const float rg = __builtin_amdgcn_rcpf(1.0f + __builtin_amdgcn_exp2f(-1.4426950408889634f * (accr[r] + brr[r])));
                  const float ig = __builtin_amdgcn_rcpf(1.0f + __builtin_amdgcn_exp2f(-1.4426950408889634f * (acci[r] + bii[r])));
                  const float a_ = __builtin_amdgcn_exp2f(-8.0f * 1.4426950408889634f * rg * sp[r]);
                  av[r] = a_; uv[r] = __builtin_amdgcn_sqrtf(fmaxf(fmaf(-a_, a_, 1.0f), 0.f)) * ig * xx[r]; }
              *(float4*)(AS + tl * EV_ROWF + w * 16 + g * 4) = make_float4(av[0], av[1], av[2], av[3]);
              *(float4*)(US + tl * EV_ROWF + w * 16 + g * 4) = make_float4(uv[0], uv[1], uv[2], uv[3]);
              __builtin_amdgcn_sched_barrier(0);
          } }
        __syncthreads();
        { const int c2 = (tix & 63) * 2, seg = tix >> 6;
          float2 av[8], uv[8];
#pragma unroll
          for (int k = 0; k < 8; ++k) { const int s = seg * 8 + k; const int tl = d == 0 ? s : 63 - s; av[k] = *(const float2*)(AS + tl * EV_ROWF + c2); uv[k] = *(const float2*)(US + tl * EV_ROWF + c2); }
          float2 hh = {0.f, 0.f}, P = {1.f, 1.f};
#pragma unroll
          for (int k = 0; k < 8; ++k) { hh.x = av[k].x * hh.x + uv[k].x; hh.y = av[k].y * hh.y + uv[k].y; P.x *= av[k].x; P.y *= av[k].y; uv[k] = hh; av[k] = P; }
          *(float2*)(SEG + seg * 128 + c2) = P; *(float2*)(SEG + 1024 + seg * 128 + c2) = hh;
          __syncthreads();
          float2 Hc = {0.f, 0.f}, Pc = {1.f, 1.f};
          for (int q = 0; q < seg; ++q) { const float2 a = *(const float2*)(SEG + q * 128 + c2), hq = *(const float2*)(SEG + 1024 + q * 128 + c2);
              Hc.x = a.x * Hc.x + hq.x; Hc.y = a.y * Hc.y + hq.y; Pc.x *= a.x; Pc.y *= a.y; }
          float2 hl = {0.f, 0.f}, pl = {1.f, 1.f};
#pragma unroll
          for (int k = 0; k < 8; ++k) { const int s = seg * 8 + k; const int tl = d == 0 ? s : 63 - s;
              hl.x = uv[k].x + av[k].x * Hc.x; hl.y = uv[k].y + av[k].y * Hc.y; pl.x = av[k].x * Pc.x; pl.y = av[k].y * Pc.y;
              const size_t o = ((size_t)d * T_ + t0 + tl) * 1024 + h * 128 + c2;
              *(unsigned*)(HL + o) = pack2bf(hl.x, hl.y); *(unsigned*)(CA + o) = pack2bf(pl.x, pl.y); }
          if (seg == 7) { const float4 ag = {pl.x, hl.x, pl.y, hl.y}; *(float4*)(AGG + (((size_t)d * 128 + c) * 1024 + h * 128 + c2) * 2) = ag; } }
    }
}

__device__ __forceinline__ void phase_even_carry(const float* __restrict__ AGG, float* __restrict__ CARRY) {
    const int tix = otid();
    const int lane = tix & 63, w = tix >> 6;
    for (int id = blockIdx.x * 8 + w; id < 2048; id += gridDim.x * 8) {
        const int ch = id & 1023, d = id >> 10;
        const int c0 = d == 0 ? 2 * lane : 127 - 2 * lane, c1 = d == 0 ? c0 + 1 : c0 - 1;
        const float2 g0 = *(const float2*)(AGG + (((size_t)d * 128 + c0) * 1024 + ch) * 2), g1 = *(const float2*)(AGG + (((size_t)d * 128 + c1) * 1024 + ch) * 2);
        float a = g0.x * g1.x, h = g1.x * g0.y + g1.y;
#pragma unroll
        for (int off = 1; off < 64; off <<= 1) { const float pa = __shfl_up(a, off), ph = __shfl_up(h, off); if (lane >= off) { h = a * ph + h; a = pa * a; } }
        float cin = __shfl_up(h, 1); if (lane == 0) cin = 0.f;
        CARRY[((size_t)d * 128 + c0) * 1024 + ch] = cin;
        CARRY[((size_t)d * 128 + c1) * 1024 + ch] = g0.x * cin + g0.y;
    }
}

__device__ __forceinline__ void bf8_to_f(const uint4 v, float (&f)[8]) {
    f[0] = __uint_as_float(v.x << 16); f[1] = __uint_as_float(v.x & 0xffff0000u); f[2] = __uint_as_float(v.y << 16); f[3] = __uint_as_float(v.y & 0xffff0000u);
    f[4] = __uint_as_float(v.z << 16); f[5] = __uint_as_float(v.z & 0xffff0000u); f[6] = __uint_as_float(v.w << 16); f[7] = __uint_as_float(v.w & 0xffff0000u); }
struct MixIn { uint4 gcm, xam, gc0, xa0, gcp, xap, gb, gg, h0, p0, h1, p1; float4 c0a, c0b, c1a, c1b; };
__device__ __forceinline__ void bf8x_to_f(const uint4 v, float (&f)[8]) {
    f[0] = __uint_as_float(v.x << 16); f[1] = __uint_as_float(v.x & 0xffff0000u); f[2] = __uint_as_float(v.y << 16); f[3] = __uint_as_float(v.y & 0xffff0000u);
    f[4] = __uint_as_float(v.z << 16); f[5] = __uint_as_float(v.z & 0xffff0000u); f[6] = __uint_as_float(v.w << 16); f[7] = __uint_as_float(v.w & 0xffff0000u); }
__device__ __forceinline__ void mix_load(MixIn& m, const bf16_t* __restrict__ Z, const bf16_t* __restrict__ HL, const bf16_t* __restrict__ CA, const float* __restrict__ CARRY, int t, int c) {
    const bf16_t* zr = Z + (size_t)t * NZ_;
    const uint4 z4 = make_uint4(0u, 0u, 0u, 0u);
    m.gcm = z4; m.xam = z4; m.gcp = z4; m.xap = z4;
    if (t > 0) { m.gcm = *(const uint4*)(zr - NZ_ + 1024 + c); m.xam = *(const uint4*)(zr - NZ_ + 2048 + c); }
    m.gc0 = *(const uint4*)(zr + 1024 + c); m.xa0 = *(const uint4*)(zr + 2048 + c);
    if (t < T_ - 1) { m.gcp = *(const uint4*)(zr + NZ_ + 1024 + c); m.xap = *(const uint4*)(zr + NZ_ + 2048 + c); }
    m.gb = *(const uint4*)(zr + c); m.gg = *(const uint4*)(zr + 4096 + c);
    const int ck = t >> 6;
    const size_t o0 = (size_t)t * 1024 + c, o1 = ((size_t)T_ + t) * 1024 + c;
    m.h0 = *(const uint4*)(HL + o0); m.p0 = *(const uint4*)(CA + o0); m.h1 = *(const uint4*)(HL + o1); m.p1 = *(const uint4*)(CA + o1);
    const float* cp0 = CARRY + (size_t)ck * 1024 + c; const float* cp1 = CARRY + ((size_t)128 + ck) * 1024 + c;
    m.c0a = *(const float4*)cp0; m.c0b = *(const float4*)(cp0 + 4); m.c1a = *(const float4*)cp1; m.c1b = *(const float4*)(cp1 + 4);
}
__device__ __forceinline__ void phase_even_mix(const bf16_t* __restrict__ Z, const float* __restrict__ ca  , const bf16_t* __restrict__ HL, const bf16_t* __restrict__ CA,
                                               const float* __restrict__ CARRY, unsigned* __restrict__ Yq, float* __restrict__ SY, unsigned char* lds) {
    const int tix = otid();
    const int c = (tix & 127) * 8, sub = tix >> 7;
    float k0[8], k1[8], k2[8];
#pragma unroll
    for (int i = 0; i < 8; ++i) { k0[i] = ca[c + i]; k1[i] = ca[1024 + c + i]; k2[i] = ca[2048 + c + i]; }
    const int step = gridDim.x * 4;
    int t = blockIdx.x * 4 + sub;
    MixIn cur, nxt;
    if (t < T_) mix_load(cur, Z, HL, CA, CARRY, t, c);
    int it = 0;
    __syncthreads();
    for (; t < T_; t += step) {
        const int tn = (t + step < T_) ? t + step : t;
        mix_load(nxt, Z, HL, CA, CARRY, tn, c);
        float s[8], a[8], b[8];
        bf8x_to_f(cur.gcm, a); bf8x_to_f(cur.xam, b);
#pragma unroll
        for (int i = 0; i < 8; ++i) s[i] = k0[i] * a[i] * b[i];
        bf8x_to_f(cur.gc0, a); bf8x_to_f(cur.xa0, b);
#pragma unroll
        for (int i = 0; i < 8; ++i) s[i] += k1[i] * a[i] * b[i];
        bf8x_to_f(cur.gcp, a); bf8x_to_f(cur.xap, b);
#pragma unroll
        for (int i = 0; i < 8; ++i) s[i] += k2[i] * a[i] * b[i];
        float gb[8], gg[8], h0[8], p0[8], h1[8], p1[8];
        bf8x_to_f(cur.gb, gb); bf8x_to_f(cur.gg, gg); bf8x_to_f(cur.h0, h0); bf8x_to_f(cur.p0, p0); bf8x_to_f(cur.h1, h1); bf8x_to_f(cur.p1, p1);
        const float cf[8] = {cur.c0a.x, cur.c0a.y, cur.c0a.z, cur.c0a.w, cur.c0b.x, cur.c0b.y, cur.c0b.z, cur.c0b.w}, cbw[8] = {cur.c1a.x, cur.c1a.y, cur.c1a.z, cur.c1a.w, cur.c1b.x, cur.c1b.y, cur.c1b.z, cur.c1b.w};
        float ya[8], yb[8]; float m = 0.f;
#pragma unroll
        for (int i = 0; i < 8; ++i) { ya[i] = gb[i] * s[i]; yb[i] = gelu_exact(gg[i]) * (h0[i] + p0[i] * cf[i] + h1[i] + p1[i] * cbw[i]); m = fmaxf(m, fmaxf(fabsf(ya[i]), fabsf(yb[i]))); }
        m = wave_max_f(m);
        float* mx = (float*)lds + (it & 1) * 8;
        if ((tix & 63) == 0) mx[tix >> 6] = m;
        __syncthreads();
        m = fmaxf(mx[sub * 2], mx[sub * 2 + 1]);
        const float sc = m > 0.f ? 127.0f / m : 0.f;
        { unsigned qa[2], qb[2];
#pragma unroll
          for (int h = 0; h < 2; ++h) {
              qa[h] = (unsigned)((int)rintf(ya[4 * h] * sc) & 255) | ((unsigned)((int)rintf(ya[4 * h + 1] * sc) & 255) << 8) | ((unsigned)((int)rintf(ya[4 * h + 2] * sc) & 255) << 16) | ((unsigned)((int)rintf(ya[4 * h + 3] * sc) & 255) << 24);
              qb[h] = (unsigned)((int)rintf(yb[4 * h] * sc) & 255) | ((unsigned)((int)rintf(yb[4 * h + 1] * sc) & 255) << 8) | ((unsigned)((int)rintf(yb[4 * h + 2] * sc) & 255) << 16) | ((unsigned)((int)rintf(yb[4 * h + 3] * sc) & 255) << 24); }
          *(uint2*)((unsigned char*)Yq + (size_t)t * D_ + c) = make_uint2(qa[0], qa[1]);
          *(uint2*)((unsigned char*)Yq + (size_t)t * D_ + 1024 + c) = make_uint2(qb[0], qb[1]); }
        if ((tix & 127) == 0) SY[t] = m * (1.0f / 127.0f);
        cur = nxt; ++it;
    }
}
__device__ __forceinline__ int at3_fk(int R) { return (R & 3) | (((R >> 3) & 3) << 2); }
#define AT5_BIAS 131072
struct At5Lane { unsigned koff, voff; int vsel; };
__device__ __forceinline__ At5Lane at5_lane(int w, int lane) {
    const int rr = lane >> 4, pc = lane & 15, R0 = 4 * w + rr; At5Lane c;
    c.koff = (unsigned)R0 * 4096u + (unsigned)((pc ^ at3_fk(R0)) << 3);
    const int gpiece = pc ^ (R0 & 15);
    c.voff = (unsigned)R0 * (unsigned)T_ + (unsigned)((gpiece & 7) << 3); c.vsel = gpiece >> 3; return c;
}
__device__ __forceinline__ void at5_issue(const bf16_t* __restrict__ QK, const bf16_t* __restrict__ Vt, PG8_LAS unsigned char* ll, int unit, int s, int buf, int w, const At5Lane& c) {
    const int r0 = (unit >> 4) * 2, h = unit & 15;
    const int lo = min(max(r0 - 4, 0), NROWS_ - 8);
    const int k0 = min(lo + 2 * s, NROWS_ - 1), k1 = min(lo + 2 * s + 1, NROWS_ - 1);
    const bf16_t* kb0 = QK + (size_t)k0 * 64 * 4096 + 2048 + h * 128 + c.koff; const bf16_t* kb1 = QK + (size_t)k1 * 64 * 4096 + 2048 + h * 128 + c.koff;
    __builtin_amdgcn_global_load_lds((const unsigned*)kb0, (PG8_LAS unsigned*)(ll + buf * 65536 + (0 * 8 + w) * 1024), 16, 0, 0);
    __builtin_amdgcn_global_load_lds((const unsigned*)(kb0 + 32 * 4096), (PG8_LAS unsigned*)(ll + buf * 65536 + (1 * 8 + w) * 1024), 16, 0, 0);
    __builtin_amdgcn_global_load_lds((const unsigned*)kb1, (PG8_LAS unsigned*)(ll + buf * 65536 + (2 * 8 + w) * 1024), 16, 0, 0);
    __builtin_amdgcn_global_load_lds((const unsigned*)(kb1 + 32 * 4096), (PG8_LAS unsigned*)(ll + buf * 65536 + (3 * 8 + w) * 1024), 16, 0, 0);
    const bf16_t* vb = Vt + (size_t)h * 128 * T_ + c.voff + (c.vsel ? k1 : k0) * 64;
#pragma unroll
    for (int i = 0; i < 4; ++i) __builtin_amdgcn_global_load_lds((const unsigned*)(vb + (size_t)i * 32 * T_), (PG8_LAS unsigned*)(ll + buf * 65536 + 32768 + (i * 8 + w) * 1024), 16, 0, 0);
}
struct At5Stage { const float* rb; unsigned char* lds;
    __device__ __forceinline__ void operator()(int i0) const { float* bl = (float*)(lds + AT5_BIAS); for (int i = i0; i < 16 * 465; i += NTHR - 64) bl[i] = rb[i]; } };
__device__ __forceinline__ void phase_attn5(const bf16_t* __restrict__ QK, const bf16_t* __restrict__ Vt, const float* __restrict__ rb, bf16_t* __restrict__ O, unsigned char* lds) {
    const int tix = otid();
    const int lane = tix & 63, w = __builtin_amdgcn_readfirstlane(tix >> 6), tokl = lane & 15, g = lane >> 4;
    const int j = w & 3, qrow = w >> 2;
    const int w0 = j == 0 ? 0 : (j == 1 ? 8 : (j == 2 ? 24 : 32));
    const int cq = 16 * j + tokl;
    const int cs = min(max(cq - 8, 0), GW_ - 16);
    float* bl = (float*)(lds + AT5_BIAS);
    const int kap = 8 * (tokl >> 2) + (tokl & 3);
    int cof[8]; float madd[8];
#pragma unroll
    for (int i = 0; i < 8; ++i) { const int kc = w0 + 8 * g + i; cof[i] = min(max(kc - cq, -15), 15) + 15; madd[i] = ((kc >= cs) && (kc < cs + 16)) ? 0.f : -INFINITY; }
    PG8_LAS unsigned char* ll = (PG8_LAS unsigned char*)lds;
    const int nmy = (1024 - (int)blockIdx.x + (int)gridDim.x - 1) / (int)gridDim.x;
    int buf = 0;
    const At5Lane lc = at5_lane(w, lane);
    if (nmy > 0) at5_issue(QK, Vt, ll, blockIdx.x, 0, 0, w, lc);
    pg8::bf16x8 bqn[4];
    { const int u0 = min((int)blockIdx.x, 1023); const int tq0 = ((u0 >> 4) * 2 + qrow) * 64 + cq;
#pragma unroll
      for (int ks = 0; ks < 4; ++ks) bqn[ks] = *(const pg8::bf16x8*)(QK + (size_t)tq0 * 4096 + (u0 & 15) * 128 + ks * 32 + g * 8); }
#pragma unroll 1
    for (int ku = 0; ku < nmy; ++ku) {
        const int unit = blockIdx.x + ku * gridDim.x;
        const int r0 = (unit >> 4) * 2, h = unit & 15;
        const int lo = min(max(r0 - 4, 0), NROWS_ - 8);
        const int r = r0 + qrow;
        const int rs = min(max(r - 4, 0), NROWS_ - 8);
        const int tq = r * 64 + cq;
        pg8::bf16x8 bq[4];
#pragma unroll
        for (int ks = 0; ks < 4; ++ks) bq[ks] = bqn[ks];
        float mrun = -INFINITY, l = 0.f;
        pg8::f32x4 Oa[8];
#pragma unroll
        for (int dt = 0; dt < 8; ++dt) Oa[dt] = (pg8::f32x4){0.f, 0.f, 0.f, 0.f};
        const float* bhead = bl + h * 465;
#pragma unroll 1
        for (int s = 0; s < 5; ++s) {
            asm volatile("s_waitcnt vmcnt(0)" ::: "memory");
            __syncthreads();
            if (s < 4) at5_issue(QK, Vt, ll, unit, s + 1, buf ^ 1, w, lc);
            else if (ku + 1 < nmy) { at5_issue(QK, Vt, ll, unit + gridDim.x, 0, buf ^ 1, w, lc);
                const int un = unit + gridDim.x; const int tqn = ((un >> 4) * 2 + qrow) * 64 + cq;
#pragma unroll
                for (int ks = 0; ks < 4; ++ks) bqn[ks] = *(const pg8::bf16x8*)(QK + (size_t)tqn * 4096 + (un & 15) * 128 + ks * 32 + g * 8); }
            const unsigned char* kb = lds + buf * 65536; const unsigned char* vbp = kb + 32768;
            pg8::f32x4 S[4];
#pragma unroll
            for (int krl = 0; krl < 2; ++krl)
#pragma unroll
                for (int hf = 0; hf < 2; ++hf) { const int R = krl * 64 + w0 + kap + 4 * hf; const int fk = at3_fk(R);
                    pg8::f32x4 acc = {0.f, 0.f, 0.f, 0.f};
#pragma unroll
                    for (int ks = 0; ks < 4; ++ks) { const pg8::bf16x8 a = *(const pg8::bf16x8*)(kb + R * 256 + (((ks * 4 + g) ^ fk) << 4)); acc = __builtin_amdgcn_mfma_f32_16x16x32_bf16(a, bq[ks], acc, 0, 0, 0); }
                    S[krl * 2 + hf] = acc; }
            float ms = -INFINITY;
#pragma unroll
            for (int krl = 0; krl < 2; ++krl) { const int krow = lo + 2 * s + krl; const bool rok = (krow >= rs) && (krow < rs + 8);
                const float rmask = rok ? 0.f : -INFINITY;
                const float* brow = bhead + min(max(krow - r + 7, 0), 14) * 31;
#pragma unroll
                for (int hf = 0; hf < 2; ++hf)
#pragma unroll
                    for (int q = 0; q < 4; ++q) { const float sv = fmaf(S[krl * 2 + hf][q], 0.08838834764831845f, brow[cof[hf * 4 + q]]) + (madd[hf * 4 + q] + rmask);
                        S[krl * 2 + hf][q] = sv; ms = fmaxf(ms, sv); } }
            ms = rows4_max(ms);
            const float mnew = fmaxf(mrun, ms);
            const float sc = __expf(mrun - mnew);
            mrun = mnew;
            l *= sc;
#pragma unroll
            for (int dt = 0; dt < 8; ++dt) { Oa[dt][0] *= sc; Oa[dt][1] *= sc; Oa[dt][2] *= sc; Oa[dt][3] *= sc; }
            pg8::bf16x8 pf[2];
#pragma unroll
            for (int krl = 0; krl < 2; ++krl) { float e[8];
#pragma unroll
                for (int hf = 0; hf < 2; ++hf)
#pragma unroll
                    for (int q = 0; q < 4; ++q) { const float pv = __expf(S[krl * 2 + hf][q] - mnew); e[hf * 4 + q] = pv; l += pv; }
                typedef unsigned u4v __attribute__((ext_vector_type(4)));
                u4v pk; pk.x = pack2bf(e[0], e[1]); pk.y = pack2bf(e[2], e[3]); pk.z = pack2bf(e[4], e[5]); pk.w = pack2bf(e[6], e[7]);
                pf[krl] = __builtin_bit_cast(pg8::bf16x8, pk); }
#pragma unroll
            for (int krl = 0; krl < 2; ++krl)
#pragma unroll
                for (int dt = 0; dt < 8; ++dt) { const int q = krl * 8 + (w0 >> 3) + g;
                    const pg8::bf16x8 a = *(const pg8::bf16x8*)(vbp + (dt * 16 + tokl) * 256 + ((q ^ tokl) << 4));
                    Oa[dt] = __builtin_amdgcn_mfma_f32_16x16x32_bf16(a, pf[krl], Oa[dt], 0, 0, 0); }
            buf ^= 1;
        }
        l = rows4_sum(l);
        const float inv = 1.0f / l;
        bf16_t* op = O + (size_t)tq * D_ + h * 128 + (g & 1) * 16 + (g >> 1) * 8;
#pragma unroll
        for (int dt = 0; dt < 8; dt += 2) {
            const unsigned ax = pack2bf(Oa[dt][0] * inv, Oa[dt][1] * inv), ay = pack2bf(Oa[dt][2] * inv, Oa[dt][3] * inv);
            const unsigned bx = pack2bf(Oa[dt + 1][0] * inv, Oa[dt + 1][1] * inv), by = pack2bf(Oa[dt + 1][2] * inv, Oa[dt + 1][3] * inv);
            const auto rx = __builtin_amdgcn_permlane16_swap(ax, bx, false, false), ry = __builtin_amdgcn_permlane16_swap(ay, by, false, false);
            *(uint4*)(op + dt * 16) = make_uint4(rx[0], ry[0], rx[1], ry[1]); }
    }
}
constexpr int EVL_SPLIT = 3;
__global__ void __launch_bounds__(512, 2) k_mega(Params p) {
    extern __shared__ __attribute__((aligned(16))) unsigned char shm[];
    if (threadIdx.x == 0) *(uint4*)(shm + LDS_BAR_OFF) = make_uint4(0u, 0u, 0u, 0u);
    __syncthreads();
    XcdBarrier bar = xcd_barrier_post(p.bar, (volatile LAS unsigned*)(shm + LDS_BAR_OFF));
    PG8_LAS unsigned char* glds = (PG8_LAS unsigned char*)shm;

    phase_cvt_x(p);
    phase_cvt_w(p, shm, (int)blockIdx.x, (int)gridDim.x, 0, 1 << 30);
    phase_cvt_gatew(p.ev_w_r, p.ev_w_i, p.Wt, (int)blockIdx.x, (int)gridDim.x);
    phase_cvt_w8(p, shm);
    phase_quant_tables_i8(p.pk_u, p.pk_v, p.Uq, p.Vq, p.SU, p.SV, (int)blockIdx.x, (int)gridDim.x, 0, 131072);
    xcd_barrier(bar);

    for (int l = 0; l < 4; ++l) {
        const int i = l >> 1;
        const bf16_t* wres;
        if ((l & 1) == 0) {
            { pg8::Gemm g{(const bf16_t*)p.xq, (const bf16_t*)(p.Win8 + (size_t)i * 5120 * 512), T_, 4096, 1024, 0}; pg8::EpiI8Bf16 e{(bf16_t*)p.Z, p.SXB, p.SWin + (size_t)i * 5120, 5120};
              pg8::StaticOrder S; S.init(g.M, g.N, (int)gridDim.x, (int)blockIdx.x);
              pg8::gemm_phase<pg8::EpiI8Bf16, pg8::StaticOrder, false, true>(glds, g, S, e, nullptr); }
            xcd_barrier(bar);
            { const int G = (int)gridDim.x, b = (int)blockIdx.x;
              if (G == 256) {
                  if (b < 128) {
                      { pg8::Gemm g{(const bf16_t*)p.xq, (const bf16_t*)(p.Win8 + ((size_t)i * 5120 + 4096) * 512), T_, 1024, 1024, 0}; pg8::EpiI8Bf16 e{(bf16_t*)p.Z + 4096, p.SXB, p.SWin + (size_t)i * 5120 + 4096, 5120};
                          pg8::StaticOrder S; S.init(g.M, g.N, 128, b);
                          pg8::gemm_phase<pg8::EpiI8Bf16, pg8::StaticOrder, false, true>(glds, g, S, e, nullptr); } }
                  const int u0 = b < 128 ? b : EVL_SPLIT * 128 + (b - 128), u1 = b < 128 ? EVL_SPLIT * 128 : 2048;
                  phase_even_local((const bf16_t*)p.Z, p.ev_conv_b_w + (size_t)i * 2 * 4 * 1024, p.ev_conv_b_b + (size_t)i * 2 * 1024, p.Wt + (size_t)i * 16 * 2 * 128 * 128,
                                   p.ev_b_r + (size_t)i * 2048, p.ev_b_i + (size_t)i * 2048, p.ev_lam + (size_t)i * 2048, (bf16_t*)p.AA, (bf16_t*)p.UU, p.XC, shm, u0, u1, 128);
              } else {
                  { pg8::Gemm g{(const bf16_t*)p.xq, (const bf16_t*)(p.Win8 + ((size_t)i * 5120 + 4096) * 512), T_, 1024, 1024, 0}; pg8::EpiI8Bf16 e{(bf16_t*)p.Z + 4096, p.SXB, p.SWin + (size_t)i * 5120 + 4096, 5120};
                    pg8::StaticOrder S; S.init(g.M, g.N, G, b);
                    pg8::gemm_phase<pg8::EpiI8Bf16, pg8::StaticOrder, false, true>(glds, g, S, e, nullptr); }
                  phase_even_local((const bf16_t*)p.Z, p.ev_conv_b_w + (size_t)i * 2 * 4 * 1024, p.ev_conv_b_b + (size_t)i * 2 * 1024, p.Wt + (size_t)i * 16 * 2 * 128 * 128,
                                   p.ev_b_r + (size_t)i * 2048, p.ev_b_i + (size_t)i * 2048, p.ev_lam + (size_t)i * 2048, (bf16_t*)p.AA, (bf16_t*)p.UU, p.XC, shm, b, 2048, G);
              } }
            xcd_barrier(bar);
            phase_even_carry(p.XC, p.XC + 524288);
            xcd_barrier(bar);
            phase_even_mix((const bf16_t*)p.Z, p.ev_conv_a + (size_t)i * 3 * 1024, (const bf16_t*)p.AA, (const bf16_t*)p.UU, p.XC + 524288, p.Yq, p.SY, shm);
            wres = p.WoutT + (size_t)i * 2048 * 2048;
        } else {
            { pg8::Gemm g{(const bf16_t*)p.xq, (const bf16_t*)(p.Wqkv8 + (size_t)i * 6144 * 512), T_, 4096, 1024, 0}; pg8::EpiI8Bf16 e{(bf16_t*)p.Z, p.SXB, p.SWqkv + (size_t)i * 6144, 4096};
              pg8::StaticOrder S; S.init(g.M, g.N, (int)gridDim.x, (int)blockIdx.x);
              pg8::gemm_phase<pg8::EpiI8Bf16, pg8::StaticOrder, false, true>(glds, g, S, e, nullptr); }
            { pg8::Gemm g{(const bf16_t*)(p.Wqkv8 + ((size_t)i * 6144 + 4096) * 512), (const bf16_t*)p.xq, 2048, T_, 1024, 0}; pg8::EpiI8Bf16 e{(bf16_t*)p.Z + (size_t)T_ * 4096, p.SWqkv + (size_t)i * 6144 + 4096, p.SXB, (size_t)T_};
              pg8::StaticOrder S; S.init(g.M, g.N, (int)gridDim.x, (int)blockIdx.x);
              pg8::gemm_phase<pg8::EpiI8Bf16, pg8::StaticOrder, false, true>(glds, g, S, e, nullptr); }
            xcd_barrier(bar, At5Stage{p.od_rel_bias + (size_t)i * 16 * 15 * 31, shm});
            phase_attn5((const bf16_t*)p.Z, (const bf16_t*)p.Z + (size_t)T_ * 4096, p.od_rel_bias + (size_t)i * 16 * 15 * 31, p.Yb, shm);
            wres = p.WoT + (size_t)i * 2048 * 2048;
        }
        xcd_barrier(bar);
        if ((l & 1) == 0) {
          pg8::Gemm g{(const bf16_t*)p.Yq, (const bf16_t*)(p.Wout8 + (size_t)i * 2048 * 512), T_, 2048, 1024, 0}; pg8::EpiI8ResB16 e{(bf16_t*)p.pre, p.xb, p.SY, p.SWout + (size_t)i * 2048, 2048, ALPHA_, 0};
          pg8::StaticOrder S; S.init(g.M, g.N, (int)gridDim.x, (int)blockIdx.x);
          pg8::gemm_phase<pg8::EpiI8ResB16, pg8::StaticOrder, false, true>(glds, g, S, e, nullptr); }
        else { pg8::Gemm g{p.Yb, wres, T_, 2048, 2048, 0}; pg8::EpiResB16 e{(bf16_t*)p.pre, p.xb, 2048, ALPHA_};
          pg8::StaticOrder S; S.init(g.M, g.N, (int)gridDim.x, (int)blockIdx.x);
          pg8::gemm_phase<pg8::EpiResB16, pg8::StaticOrder, false>(glds, g, S, e, nullptr); }
        xcd_barrier(bar);
        phase_lnq<false>((const bf16_t*)p.pre, (const bf16_t*)nullptr, p.ln1_g + (size_t)l * D_, p.ln1_b + (size_t)l * D_, (float*)nullptr, p.x1b, p.x1q, p.SX);
        xcd_barrier(bar);
        { pg8::Gemm g{(const bf16_t*)p.x1q, (const bf16_t*)(p.Wq8 + (size_t)l * 2048 * 512), T_, 2048, 1024, 0}; pg8::EpiI8Bf16 e{(bf16_t*)p.Z, p.SX, p.SW + (size_t)l * 2048, 2048};
          pg8::StaticOrder S; S.init(g.M, g.N, (int)gridDim.x, (int)blockIdx.x);
          pg8::gemm_phase<pg8::EpiI8Bf16, pg8::StaticOrder, false, true>(glds, g, S, e, nullptr); }
        xcd_barrier(bar, TopkStage{p.pk_sub_keys + (size_t)l * 2 * 128 * 128, shm});
        phase_topk((const bf16_t*)p.Z, p.pk_sub_keys + (size_t)l * 2 * 128 * 128, (unsigned short*)p.Eb, p.Gb, shm, p.SU + (size_t)l * 16384, p.SV + (size_t)l * 16384, p.SUE);
        xcd_barrier(bar);
        phase_gather_u4(p.x1q, p.Uq + (size_t)l * 16384 * 256, (const unsigned short*)p.Eb, (int*)p.XC, shm);
        xcd_barrier(bar);
        phase_peer_fin(p.Gb, p.SUE, (const int*)p.XC, p.SX, p.WQ, p.WSC, (unsigned short*)p.Eb);
        xcd_barrier(bar);
        phase_gather_v8k((bf16_t*)p.pre, p.Vq + (size_t)l * 16384 * 512, (const unsigned short*)p.Eb, p.WQ, p.WSC, shm);
        xcd_barrier(bar);
        phase_lnq<true>(p.x1b, (const bf16_t*)p.pre, p.ln2_g + (size_t)l * D_, p.ln2_b + (size_t)l * D_, (l == 3) ? p.out : (float*)nullptr, (l == 3) ? (bf16_t*)nullptr : p.xb, (l == 3) ? (unsigned*)nullptr : p.xq, (l == 3) ? (float*)nullptr : p.SXB);
        if (l < 3) xcd_barrier(bar);
    }
}

struct WsAlloc { char* base; size_t off; void* get(size_t bytes) { void* q = base + off; off += (bytes + 255) & ~(size_t)255; return q; } };

extern "C" void kernel_launch(void* const* d_in, const int* in_sizes, int n_in, void* d_out, int out_size, void* d_ws, size_t ws_size, hipStream_t stream) {
    Params p; memset(&p, 0, sizeof(p));
    p.x = (const float*)d_in[0]; p.ev_w_in = (const float*)d_in[1]; p.ev_conv_a = (const float*)d_in[2]; p.ev_conv_b_w = (const float*)d_in[3]; p.ev_conv_b_b = (const float*)d_in[4];
    p.ev_w_r = (const float*)d_in[5]; p.ev_b_r = (const float*)d_in[6]; p.ev_w_i = (const float*)d_in[7]; p.ev_b_i = (const float*)d_in[8]; p.ev_lam = (const float*)d_in[9];
    p.ev_w_out = (const float*)d_in[10]; p.od_w_qkv = (const float*)d_in[11]; p.od_rel_bias = (const float*)d_in[12]; p.od_w_o = (const float*)d_in[13]; p.pk_w_q = (const float*)d_in[14];
    p.pk_sub_keys = (const float*)d_in[15]; p.pk_u = (const float*)d_in[16]; p.pk_v = (const float*)d_in[17];
    p.ln1_g = (const float*)d_in[18]; p.ln1_b = (const float*)d_in[19]; p.ln2_g = (const float*)d_in[20]; p.ln2_b = (const float*)d_in[21];
    p.out = (float*)d_out;
    WsAlloc W{(char*)d_ws, 0};
    const size_t TD = (size_t)T_ * D_;
    p.bar = (unsigned*)W.get(XCD_BAR_WORDS * sizeof(unsigned));
    p.xb  = (bf16_t*)W.get(TD * 2); p.x1f = (float*)W.get(TD * 4); p.x1b = (bf16_t*)W.get(TD * 2); p.x2f = (float*)W.get(TD * 4); p.pre = (float*)W.get(TD * 4);
    p.Z   = (float*)W.get((size_t)T_ * 6144 * 4); p.Yb = (bf16_t*)W.get(TD * 2);
    p.WinT = (bf16_t*)W.get((size_t)2 * 5120 * 2048 * 2); p.WoutT = (bf16_t*)W.get((size_t)2 * 2048 * 2048 * 2); p.WqkvT = (bf16_t*)W.get((size_t)2 * 6144 * 2048 * 2);
    p.WoT = (bf16_t*)W.get((size_t)2 * 2048 * 2048 * 2); p.WqT = (bf16_t*)W.get((size_t)4 * 2048 * 2048 * 2);
    p.XC = (float*)W.get((size_t)2 * T_ * 1024 * 4); p.AA = (float*)W.get((size_t)2 * T_ * 1024 * 4); p.UU = (float*)W.get((size_t)2 * T_ * 1024 * 4);
    p.Eb = (int*)W.get((size_t)T_ * 128 * 4); p.Gb = (float*)W.get((size_t)T_ * 128 * 4);
    p.Wt = (bf16_t*)W.get((size_t)2 * 16 * 2 * 128 * 128 * 2);
    p.Uq = (unsigned*)W.get((size_t)4 * 16384 * 2048); p.Vq = (unsigned*)W.get((size_t)4 * 16384 * 2048); p.SU = (float*)W.get((size_t)4 * 16384 * 4); p.SV = (float*)W.get((size_t)4 * 16384 * 4);
    p.SUE = (float*)W.get((size_t)T_ * 128 * 4); p.WQ = (unsigned char*)W.get((size_t)T_ * 128); p.WSC = (float*)W.get((size_t)T_ * 4); p.x1q = (unsigned*)W.get((size_t)T_ * 2048); p.SX = (float*)W.get((size_t)T_ * 4);
    p.Wq8 = (unsigned*)W.get((size_t)4 * 2048 * 2048); p.SW = (float*)W.get((size_t)4 * 2048 * 4);
    p.Win8 = (unsigned*)W.get((size_t)2 * 5120 * 2048); p.SWin = (float*)W.get((size_t)2 * 5120 * 4); p.Wqkv8 = (unsigned*)W.get((size_t)2 * 6144 * 2048); p.SWqkv = (float*)W.get((size_t)2 * 6144 * 4);
    p.xq = (unsigned*)W.get((size_t)T_ * 2048); p.SXB = (float*)W.get((size_t)T_ * 4);
    p.Yq = (unsigned*)W.get((size_t)T_ * 2048); p.SY = (float*)W.get((size_t)T_ * 4); p.Wout8 = (unsigned*)W.get((size_t)2 * 2048 * 2048); p.SWout = (float*)W.get((size_t)2 * 2048 * 4);

    if (W.off > ws_size) return;
    static int grid = 0;
    if (!grid) {
        (void)hipFuncSetAttribute((const void*)k_mega, hipFuncAttributeMaxDynamicSharedMemorySize, LDS_BYTES);
        int dev = 0, cus = 0, per_cu = 0;
        (void)hipGetDevice(&dev);
        (void)hipDeviceGetAttribute(&cus, hipDeviceAttributeMultiprocessorCount, dev);
        (void)hipOccupancyMaxActiveBlocksPerMultiprocessor(&per_cu, (const void*)k_mega, 512, LDS_BYTES);
        if (cus <= 0) cus = 256;
        grid = cus * (per_cu < 1 ? 1 : 1);
    }
    (void)hipMemsetAsync(p.bar, 0, XCD_BAR_WORDS * sizeof(unsigned), stream);
    hipLaunchKernelGGL(k_mega, dim3(grid), dim3(512), LDS_BYTES, stream, p);
}
```
